# Optimizing an MI355X kernel written in HIP

```python
import math
import jax, jax.numpy as jnp
from jax import lax
import numpy as np

D_MODEL = 1024
BATCH = 2
SEQ = 8192
DEPTH = 1

CHUNK = 64
N_META = 16
QBLK = 128
SB_HEADS = 8
SB_HEAD_DIM = D_MODEL // SB_HEADS
DF_HEADS = 8
DF_HEAD_DIM = D_MODEL // (2 * DF_HEADS)
SB_W = SB_HEADS * SB_HEAD_DIM
DF_QK_W = DF_HEADS * 2 * DF_HEAD_DIM
DF_V_W = DF_HEADS * 2 * DF_HEAD_DIM
IN_W = 3 * SB_W + 2 * DF_QK_W + DF_V_W
D_FF = -(-(8 * D_MODEL) // (3 * 256)) * 256
EPS = 1e-6

kernel_name = 'hybrid_stickbreak_diffattn_block'


def rmsnorm(x, g):
    xf = x.astype(jnp.float32)
    y = xf * lax.rsqrt(jnp.mean(xf * xf, axis=-1, keepdims=True) + EPS)
    return (y * g.astype(jnp.float32)).astype(x.dtype)


def stick_breaking_block(q, k, v, qpos, kpos):
    z = jnp.einsum('bhqd,bhkd->bhqk', q, k).astype(jnp.float32) * (SB_HEAD_DIM ** -0.5)
    causal = kpos[None, :] < qpos[:, None]
    u = jnp.where(causal, jax.nn.log_sigmoid(-z), 0.0)
    rest = lax.cumsum(u, axis=3, reverse=True) - u
    log_a = jax.nn.log_sigmoid(z) + rest
    a = jnp.where(causal, jnp.exp(log_a), 0.0)
    return jnp.einsum('bhqk,bhkd->bhqd', a.astype(v.dtype), v)


def diff_attn_block(q, k, v, lam, slopes, qpos, kpos, qcid, kcid):
    s = jnp.einsum('bhcqd,bhckd->bhcqk', q, k).astype(jnp.float32) * (DF_HEAD_DIM ** -0.5)
    dist = jnp.abs(qpos[:, None] - kpos[None, :]).astype(jnp.float32)
    bias = -slopes[:, None, None] * dist
    mask = kcid[None, :] <= qcid[:, None]
    s = jnp.where(mask, s + bias[None, :, None], -jnp.inf)
    p = jax.nn.softmax(s, axis=-1)
    w = p[:, :, 0] - lam * p[:, :, 1]
    return jnp.einsum('bhqk,bhkd->bhqd', w.astype(v.dtype), v)


def setup_inputs(seed: int = 0) -> dict:
    key = jax.random.key(seed)
    ks = jax.random.split(key, 20)
    f32 = jnp.float32
    nrm = lambda k, shape, scale: (jax.random.normal(k, shape, f32) * scale)
    gain = lambda k, shape: 1.0 + 0.05 * jax.random.normal(k, shape, f32)
    return {
        'x': jax.random.normal(ks[0], (BATCH, SEQ, D_MODEL), f32),
        'meta': nrm(ks[1], (N_META, D_MODEL), 1.0),
        'norm_mix_g': gain(ks[2], (DEPTH, D_MODEL)),
        'w_in': nrm(ks[3], (DEPTH, D_MODEL, IN_W), D_MODEL ** -0.5),
        'w_gate': nrm(ks[4], (DEPTH, D_MODEL, 2 * D_MODEL), D_MODEL ** -0.5),
        'b_gate': nrm(ks[5], (DEPTH, 2 * D_MODEL), 0.1),
        'lam_q1': nrm(ks[6], (DEPTH, DF_HEAD_DIM), 0.1),
        'lam_k1': nrm(ks[7], (DEPTH, DF_HEAD_DIM), 0.1),
        'lam_q2': nrm(ks[8], (DEPTH, DF_HEAD_DIM), 0.1),
        'lam_k2': nrm(ks[9], (DEPTH, DF_HEAD_DIM), 0.1),
        'subln_g': gain(ks[10], (DEPTH, 2 * DF_HEAD_DIM)),
        'w_br_sb': nrm(ks[11], (DEPTH, SB_W, D_MODEL), SB_W ** -0.5),
        'w_br_df': nrm(ks[12], (DEPTH, DF_V_W, D_MODEL), DF_V_W ** -0.5),
        'w_out': nrm(ks[13], (DEPTH, D_MODEL, D_MODEL), D_MODEL ** -0.5),
        'norm_ffn_g': gain(ks[14], (DEPTH, D_MODEL)),
        'w_ffn_gate': nrm(ks[15], (DEPTH, D_MODEL, D_FF), D_MODEL ** -0.5),
        'w_ffn_up': nrm(ks[16], (DEPTH, D_MODEL, D_FF), D_MODEL ** -0.5),
        'w_ffn_down': nrm(ks[17], (DEPTH, D_FF, D_MODEL), D_FF ** -0.5),
        'norm_final_g': gain(ks[18], (D_MODEL,)),
    }


def reference(x, meta, norm_mix_g, w_in, w_gate, b_gate, lam_q1, lam_k1, lam_q2, lam_k2,
              subln_g, w_br_sb, w_br_df, w_out, norm_ffn_g, w_ffn_gate, w_ffn_up,
              w_ffn_down, norm_final_g):
    B, S, D = x.shape
    L = N_META + S
    L_pad = -(-L // QBLK) * QBLK
    h = jnp.concatenate([
        jnp.broadcast_to(meta[None].astype(x.dtype), (B, N_META, D)),
        x,
        jnp.zeros((B, L_pad - L, D), x.dtype)], axis=1)
    pos = jnp.arange(L_pad)
    cid = jnp.where(pos < N_META, 0, (pos - N_META) // CHUNK + 1)
    slopes = jnp.exp2(-8.0 * (jnp.arange(DF_HEADS) + 1) / DF_HEADS).astype(jnp.float32)
    splits = [SB_W, 2 * SB_W, 3 * SB_W, 3 * SB_W + DF_QK_W, 3 * SB_W + 2 * DF_QK_W]

    for l in range(DEPTH):
        lam_init = 0.8 - 0.6 * math.exp(-0.3 * l)
        xn = rmsnorm(h, norm_mix_g[l])
        proj = xn @ w_in[l]
        sb_q, sb_k, sb_v, df_q, df_k, df_v = jnp.split(proj, splits, axis=-1)
        to_heads = lambda t, nh, dh: t.reshape(B, L_pad, nh, dh).transpose(0, 2, 1, 3)
        sq = to_heads(sb_q, SB_HEADS, SB_HEAD_DIM)
        sk = to_heads(sb_k, SB_HEADS, SB_HEAD_DIM)
        sv = to_heads(sb_v, SB_HEADS, SB_HEAD_DIM)
        dq = df_q.reshape(B, L_pad, DF_HEADS, 2, DF_HEAD_DIM).transpose(0, 2, 3, 1, 4)
        dk = df_k.reshape(B, L_pad, DF_HEADS, 2, DF_HEAD_DIM).transpose(0, 2, 3, 1, 4)
        dv = to_heads(df_v, DF_HEADS, 2 * DF_HEAD_DIM)
        lam = (jnp.exp(jnp.sum(lam_q1[l].astype(jnp.float32) * lam_k1[l].astype(jnp.float32)))
               - jnp.exp(jnp.sum(lam_q2[l].astype(jnp.float32) * lam_k2[l].astype(jnp.float32)))
               + lam_init)

        sb_blocks = []
        df_blocks = []
        for i in range(L_pad // QBLK):
            q0 = i * QBLK
            qe = q0 + QBLK
            lk = min(qe + CHUNK, L_pad)
            sb_blocks.append(stick_breaking_block(
                sq[:, :, q0:qe], sk[:, :, :qe], sv[:, :, :qe], pos[q0:qe], pos[:qe]))
            df_blocks.append(diff_attn_block(
                dq[:, :, :, q0:qe], dk[:, :, :, :lk], dv[:, :, :lk], lam, slopes,
                pos[q0:qe], pos[:lk], cid[q0:qe], cid[:lk]))
        o_sb = jnp.concatenate(sb_blocks, axis=2).transpose(0, 2, 1, 3).reshape(B, L_pad, SB_W)
        o_df = jnp.concatenate(df_blocks, axis=2)
        o_df = (rmsnorm(o_df, subln_g[l]) * (1.0 - lam_init)).transpose(0, 2, 1, 3).reshape(B, L_pad, DF_V_W)

        y_sb = o_sb @ w_br_sb[l]
        y_df = o_df @ w_br_df[l]
        gates = jax.nn.sigmoid(xn @ w_gate[l] + b_gate[l]).reshape(B, L_pad, 2, D)
        merged = gates[:, :, 0] * y_sb + gates[:, :, 1] * y_df
        h = h + merged @ w_out[l]

        hn = rmsnorm(h, norm_ffn_g[l])
        h = h + (jax.nn.silu(hn @ w_ffn_gate[l]) * (hn @ w_ffn_up[l])) @ w_ffn_down[l]

    y = rmsnorm(h, norm_final_g)
    return y[:, N_META:N_META + S]
```

```cpp
#include <hip/hip_runtime.h>
#include <hip/hip_cooperative_groups.h>
#include <cstdio>
#include <cstdint>
namespace cg = cooperative_groups;

#ifndef MK_N_LAUNCHES
#define MK_N_LAUNCHES 8
#endif
#ifndef SB_EARLY_EXIT
#define SB_EARLY_EXIT 1
#endif

#define LAS __attribute__((address_space(3)))
typedef unsigned short bf16_t;
typedef short bf16x8 __attribute__((ext_vector_type(8)));
typedef float f32x4 __attribute__((ext_vector_type(4)));
typedef float f32x16 __attribute__((ext_vector_type(16)));
typedef unsigned u32x4 __attribute__((ext_vector_type(4)));
typedef unsigned u32x2 __attribute__((ext_vector_type(2)));
typedef float f32x2_t __attribute__((ext_vector_type(2)));
typedef __bf16 bf16x2_t __attribute__((ext_vector_type(2)));

constexpr int SEQ = 8192, DM = 1024, MROWS = 2 * SEQ, NMETA = 16, DFF = 2816;
constexpr float EPS = 1e-6f;
constexpr float LOG2E = 1.4426950408889634f;
constexpr int NWAVES = 8, NTHREADS = 512;
constexpr int PROJ_LD = 4096;
constexpr int PC_SBQ = 0, PC_SBK = 1024, PC_DFQ = 2048, PC_DFK = 3072;

constexpr size_t MiB = 1u << 20;
constexpr size_t WS_CTL = 0, CTL_BYTES = 1 * MiB;
constexpr size_t CTL_QUEUE = 256;
constexpr size_t CTL_SS1 = 256 * 1024, CTL_SS2 = 512 * 1024;
constexpr size_t WS_W1T = 1 * MiB;
constexpr size_t WS_METAK = 17 * MiB;
constexpr size_t WS_METAV = WS_METAK + 512 * 1024;
constexpr size_t WS_XN = 18 * MiB;
constexpr size_t WS_WBR = 18 * MiB;
constexpr size_t WS_WOUT2 = 22 * MiB;
constexpr size_t WS_WFFN = 26 * MiB;
constexpr size_t WS_WDOWN = 38 * MiB;
constexpr size_t WS_PROJ = 50 * MiB;
constexpr size_t WS_H1B = 50 * MiB;
constexpr size_t WS_ACT = 82 * MiB;
constexpr size_t WS_GATES = 178 * MiB;
constexpr size_t WS_H1 = 178 * MiB;
constexpr size_t WS_END = 242 * MiB;

__device__ __forceinline__ unsigned cvtpk(float lo, float hi) { f32x2_t v = {lo, hi}; bf16x2_t b = __builtin_convertvector(v, bf16x2_t); return __builtin_bit_cast(unsigned, b); }
__device__ __forceinline__ float bf2f(unsigned short b) { return __builtin_bit_cast(float, (unsigned)b << 16); }
__device__ __forceinline__ float wave_sum(float v) {
#pragma unroll
    for (int o = 1; o < 64; o <<= 1) v += __shfl_xor(v, o);
    return v;
}
__device__ __forceinline__ float fast_sigmoid(float x) { return __builtin_amdgcn_rcpf(1.0f + __builtin_amdgcn_exp2f(-x * LOG2E)); }

namespace pg8 {
constexpr int BM = 256, BK = 64, HALF = 128, HTB = HALF * BK * 2, STAGE_BYTES = 8 * HTB, NXCD = 8, WGM = 8;
__host__ __device__ __forceinline__ int lds_byte(int r, int c) { const int st = (r >> 4) * 2 + (c >> 5), rr = r & 15, cc = c & 31, ob = rr * 64 + cc * 2; return st * 1024 + (ob ^ (((ob >> 9) & 1) << 5)); }
__host__ __device__ __forceinline__ void stage_rc(int b, int& R, int& C) { const int st = b / 1024, sb = b % 1024, swz = sb ^ (((sb >> 9) & 1) << 5); R = (st >> 1) * 16 + swz / 64; C = (st & 1) * 32 + (swz % 64) / 2; }
__host__ __device__ __forceinline__ int perm32(int rho) { const int n = rho >> 4, i = rho & 15; return 8 * (i >> 2) + 4 * n + (i & 3); }

struct Unit { int pm, pn, kind; const char* A; const char* B; };
__device__ __forceinline__ void tile_order(int wgid, int nM, int nN, int& pm, int& pn) {
    const int nwg = nM * nN;
    { const int q = nwg / NXCD, r = nwg % NXCD, xcd = wgid % NXCD, off = wgid / NXCD; wgid = (xcd < r ? xcd * (q + 1) : r * (q + 1) + (xcd - r) * q) + off; }
    const int nig = WGM * nN, gid = wgid / nig, fm = gid * WGM, gsz = (nM - fm) < WGM ? (nM - fm) : WGM;
    pm = fm + ((wgid % nig) % gsz); pn = (wgid % nig) / gsz;
}
template <class Epi, class Sched, bool ALIGN_EPI>
__device__ __forceinline__ void gemm_phase(LAS unsigned char* lds, const int K, const int lda, const int ldb, const Sched& S, const Epi& E) {
    const int tid = threadIdx.x, wid = __builtin_amdgcn_readfirstlane(tid >> 6), lane = tid & 63, wr = wid >> 2, wc = wid & 3, fr = lane & 15, fq = lane >> 4;
    const int nt = K / BK;
    unsigned voffA[2], voffB[2];
#pragma unroll
    for (int i = 0; i < 2; ++i) { int R, C; stage_rc(tid * 16 + i * 8192, R, C); const int Rb = Epi::PERM ? ((R & ~31) + perm32(R & 31)) : R;
        voffA[i] = (unsigned)(R * lda + C) * 2u; voffB[i] = (unsigned)(Rb * ldb + C) * 2u; }
    const size_t kstep = (size_t)(BK * 2);
    const size_t hstepA = (size_t)HALF * lda * 2, hstepB = (size_t)HALF * ldb * 2;
    const unsigned ldsw = (unsigned)wid * 1024u;
    const int aoff = lds_byte(wr * 64 + fr, fq * 8), boff = lds_byte(wc * 32 + fr, fq * 8);
#define PG8_SA(b, h) (((b) * 2 + (h)) * HTB)
#define PG8_SB(b, h) ((4 + (b) * 2 + (h)) * HTB)
#define PG8_STAGE(bufoff, gbase, voff) do { _Pragma("unroll") for (int _i = 0; _i < 2; ++_i) \
        __builtin_amdgcn_global_load_lds((const unsigned*)((const char*)(gbase) + (voff)[_i]), (LAS unsigned*)(lds + (bufoff) + ldsw + _i * 8192), 16, 0, 0); } while (0)
#define PG8_LDA(dst, b, h) do { _Pragma("unroll") for (int m = 0; m < 4; ++m) _Pragma("unroll") for (int k = 0; k < 2; ++k) dst[m][k] = *(const LAS bf16x8*)(lds + PG8_SA(b, h) + aoff + m * 2048 + k * 1024); } while (0)
#define PG8_LDB(dst, b, h) do { _Pragma("unroll") for (int n = 0; n < 2; ++n) _Pragma("unroll") for (int k = 0; k < 2; ++k) dst[n][k] = *(const LAS bf16x8*)(lds + PG8_SB(b, h) + boff + n * 2048 + k * 1024); } while (0)
#define PG8_MMA(ai, bj, At, Bt) do { __builtin_amdgcn_s_setprio(1); _Pragma("unroll") for (int m = 0; m < 4; ++m) _Pragma("unroll") for (int n = 0; n < 2; ++n) _Pragma("unroll") for (int k = 0; k < 2; ++k) \
        acc[ai][bj][m][n] = __builtin_amdgcn_mfma_f32_16x16x32_bf16(Bt[n][k], At[m][k], acc[ai][bj][m][n], 0, 0, 0); __builtin_amdgcn_s_setprio(0); } while (0)
#define PG8_WAIT_V(n) asm volatile("s_waitcnt vmcnt(" #n ")" ::: "memory")
#define PG8_WAIT_L(n) asm volatile("s_waitcnt lgkmcnt(" #n ")" ::: "memory")
#define PG8_BAR __builtin_amdgcn_s_barrier()
#define PG8_SCHED __builtin_amdgcn_sched_barrier(0)
    Unit cur, nxt; int ui = 0;
    if (!S.next(0, cur)) return;
    f32x4 acc[2][2][4][2];
#pragma unroll
    for (int a = 0; a < 2; ++a)
#pragma unroll
        for (int b = 0; b < 2; ++b)
#pragma unroll
            for (int m = 0; m < 4; ++m)
#pragma unroll
                for (int n = 0; n < 2; ++n) acc[a][b][m][n] = (f32x4){0.f, 0.f, 0.f, 0.f};
    bf16x8 At[4][2], B0[2][2], B1[2][2];
    const char* cA = cur.A; const char* cB = cur.B;
    PG8_STAGE(PG8_SB(0, 0), cB, voffB); PG8_STAGE(PG8_SB(0, 1), cB + hstepB, voffB); PG8_STAGE(PG8_SA(0, 0), cA, voffA); PG8_STAGE(PG8_SA(0, 1), cA + hstepA, voffA);
    if (wr == 1) PG8_BAR;
    PG8_WAIT_V(2); PG8_BAR;
    PG8_STAGE(PG8_SB(1, 0), cB + kstep, voffB); PG8_STAGE(PG8_SA(1, 0), cA + kstep, voffA); PG8_STAGE(PG8_SB(1, 1), cB + hstepB + kstep, voffB);
    PG8_WAIT_V(6); PG8_BAR;
    for (;;) {
        const bool has_next = S.next(ui + 1, nxt);
        const char* nA = has_next ? nxt.A : cA; const char* nB = has_next ? nxt.B : cB;
        for (int t = 0; t < nt; t += 2) {
            const bool last = (t == nt - 2);
            const char* a1 = cA + (size_t)(t + 1) * kstep;
            const char* a2 = last ? nA : cA + (size_t)(t + 2) * kstep; const char* b2 = last ? nB : cB + (size_t)(t + 2) * kstep;
            const char* a3 = a2 + kstep; const char* b3 = b2 + kstep;
            PG8_LDB(B0, 0, 0); PG8_LDB(B1, 0, 1); PG8_SCHED; PG8_LDA(At, 0, 0); PG8_STAGE(PG8_SA(1, 1), a1 + hstepA, voffA);
            PG8_WAIT_V(8); PG8_WAIT_L(0); PG8_BAR; PG8_MMA(0, 0, At, B0); PG8_MMA(0, 1, At, B1); PG8_BAR; PG8_SCHED;
            PG8_LDA(At, 0, 1); PG8_STAGE(PG8_SB(0, 0), b2, voffB); PG8_STAGE(PG8_SB(0, 1), b2 + hstepB, voffB); PG8_STAGE(PG8_SA(0, 0), a2, voffA);
            PG8_WAIT_V(8); PG8_WAIT_L(0); PG8_BAR; PG8_MMA(1, 0, At, B0); PG8_MMA(1, 1, At, B1); PG8_BAR; PG8_SCHED;
            PG8_LDB(B0, 1, 0); PG8_LDB(B1, 1, 1); PG8_SCHED; PG8_LDA(At, 1, 0); PG8_STAGE(PG8_SA(0, 1), a2 + hstepA, voffA);
            PG8_WAIT_V(8); PG8_WAIT_L(0); PG8_BAR; PG8_MMA(0, 0, At, B0); PG8_MMA(0, 1, At, B1); PG8_BAR; PG8_SCHED;
            PG8_LDA(At, 1, 1); PG8_STAGE(PG8_SB(1, 0), b3, voffB); PG8_STAGE(PG8_SB(1, 1), b3 + hstepB, voffB); PG8_STAGE(PG8_SA(1, 0), a3, voffA);
            PG8_WAIT_V(8); PG8_WAIT_L(0); PG8_BAR; PG8_MMA(1, 0, At, B0); PG8_MMA(1, 1, At, B1); PG8_BAR; PG8_SCHED;
        }
        if constexpr (ALIGN_EPI) { if (wr == 0) PG8_BAR; }
        E(acc, cur, wr, wc, fr, fq);
        if (!has_next) break;
#pragma unroll
        for (int a = 0; a < 2; ++a)
#pragma unroll
            for (int b = 0; b < 2; ++b)
#pragma unroll
                for (int m = 0; m < 4; ++m)
#pragma unroll
                    for (int n = 0; n < 2; ++n) acc[a][b][m][n] = (f32x4){0.f, 0.f, 0.f, 0.f};
        cur = nxt; cA = nA; cB = nB; ++ui;
        if constexpr (ALIGN_EPI) { if (wr == 1) PG8_BAR; }
    }
    PG8_WAIT_V(0);
    if constexpr (!ALIGN_EPI) { if (wr == 0) PG8_BAR; }
    PG8_BAR;
#undef PG8_SA
#undef PG8_SB
#undef PG8_STAGE
#undef PG8_LDA
#undef PG8_LDB
#undef PG8_MMA
#undef PG8_WAIT_V
#undef PG8_WAIT_L
#undef PG8_BAR
#undef PG8_SCHED
}
}

using pg8::Unit;
struct SchedP1 {
    const char* XN; const char* W1T; int G, c;
    __device__ __forceinline__ bool next(int i, Unit& u) const {
        const int L = i * G + c; if (L >= 2048) return false;
        if (L < 1536) { pg8::tile_order(L, 64, 24, u.pm, u.pn); u.kind = (u.pn < 16) ? 0 : 1; u.A = XN + (size_t)u.pm * 256 * 1024 * 2; u.B = W1T + (size_t)u.pn * 256 * 1024 * 2; }
        else { pg8::tile_order(L - 1536, 8, 64, u.pm, u.pn); u.kind = 2; u.A = W1T + (size_t)(6144 + u.pm * 256) * 1024 * 2; u.B = XN + (size_t)u.pn * 256 * 1024 * 2; }
        return true;
    }
};
struct EpiP1 {
    static constexpr bool PERM = true;
    bf16_t* PROJ; bf16_t* GATES; bf16_t* VT; const float* bgate;
    __device__ __forceinline__ void operator()(const f32x4 (&acc)[2][2][4][2], const Unit& u, int wr, int wc, int fr, int fq) const {
        bf16_t* base; int ldc, colt; const float* bias = nullptr;
        if (u.kind == 0) { base = PROJ; ldc = PROJ_LD; colt = u.pn * 256; }
        else if (u.kind == 1) { base = GATES; ldc = 2048; colt = (u.pn - 16) * 256; bias = bgate + colt; }
        else { base = VT; ldc = MROWS; colt = u.pn * 256; }
        const int row0 = u.pm * 256 + wr * 64 + fr, col0 = colt + wc * 32 + 8 * fq;
        f32x4 bv[2][2];
#pragma unroll
        for (int bj = 0; bj < 2; ++bj)
#pragma unroll
            for (int n = 0; n < 2; ++n) bv[bj][n] = bias ? *(const f32x4*)(bias + wc * 32 + 8 * fq + bj * 128 + 4 * n) : (f32x4){0.f, 0.f, 0.f, 0.f};
#pragma unroll
        for (int ai = 0; ai < 2; ++ai)
#pragma unroll
            for (int m = 0; m < 4; ++m) { bf16_t* rowp = base + (size_t)(row0 + ai * 128 + m * 16) * ldc + col0;
#pragma unroll
                for (int bj = 0; bj < 2; ++bj) { f32x4 v0 = acc[ai][bj][m][0] + bv[bj][0], v1 = acc[ai][bj][m][1] + bv[bj][1];
                    if (u.kind == 1) {
#pragma unroll
                        for (int i = 0; i < 4; ++i) { v0[i] = fast_sigmoid(v0[i]); v1[i] = fast_sigmoid(v1[i]); } }
                    u32x4 w; w.x = cvtpk(v0[0], v0[1]); w.y = cvtpk(v0[2], v0[3]); w.z = cvtpk(v1[0], v1[1]); w.w = cvtpk(v1[2], v1[3]);
                    *(u32x4*)(rowp + bj * 128) = w; } }
    }
};
struct SchedP3 {
    const char* PROJ; const char* WBR; int G, c;
    __device__ __forceinline__ bool next(int i, Unit& u) const {
        const int L = i * G + c; if (L >= 512) return false;
        pg8::tile_order(L, 64, 8, u.pm, u.pn); u.kind = 0;
        u.A = PROJ + ((size_t)u.pm * 256 * PROJ_LD + (u.pn < 4 ? PC_SBQ : PC_DFQ)) * 2; u.B = WBR + (size_t)u.pn * 256 * 1024 * 2; return true;
    }
};
struct EpiP3 {
    static constexpr bool PERM = true;
    const bf16_t* GATES; bf16_t* Y;
    __device__ __forceinline__ void operator()(const f32x4 (&acc)[2][2][4][2], const Unit& u, int wr, int wc, int fr, int fq) const {
        const int row0 = u.pm * 256 + wr * 64 + fr, col0 = u.pn * 256 + wc * 32 + 8 * fq;
#pragma unroll
        for (int ai = 0; ai < 2; ++ai)
#pragma unroll
            for (int m = 0; m < 4; ++m) { const size_t off = (size_t)(row0 + ai * 128 + m * 16) * 2048 + col0;
#pragma unroll
                for (int bj = 0; bj < 2; ++bj) { const u32x4 g = *(const u32x4*)(GATES + off + bj * 128);
                    const f32x4 v0 = acc[ai][bj][m][0], v1 = acc[ai][bj][m][1]; u32x4 w;
                    w.x = cvtpk(v0[0] * bf2f(g.x & 0xffff), v0[1] * bf2f(g.x >> 16)); w.y = cvtpk(v0[2] * bf2f(g.y & 0xffff), v0[3] * bf2f(g.y >> 16));
                    w.z = cvtpk(v1[0] * bf2f(g.z & 0xffff), v1[1] * bf2f(g.z >> 16)); w.w = cvtpk(v1[2] * bf2f(g.w & 0xffff), v1[3] * bf2f(g.w >> 16));
                    *(u32x4*)(Y + off + bj * 128) = w; } }
    }
};
struct SchedN1024 {
    const char* A; const char* B; size_t lda_b, ldb_b; int G, c;
    __device__ __forceinline__ bool next(int i, Unit& u) const {
        const int L = i * G + c; if (L >= 256) return false;
        pg8::tile_order(L, 64, 4, u.pm, u.pn); u.kind = 0; u.A = A + (size_t)u.pm * 256 * lda_b; u.B = B + (size_t)u.pn * 256 * ldb_b; return true;
    }
};
struct EpiRes {
    static constexpr bool PERM = false;
    const float* base; float* out; bf16_t* outb; float* ss;
    __device__ __forceinline__ void operator()(const f32x4 (&acc)[2][2][4][2], const Unit& u, int wr, int wc, int fr, int fq) const {
        const int col0 = u.pn * 256 + wc * 32 + 4 * fq;
#pragma unroll
        for (int ai = 0; ai < 2; ++ai)
#pragma unroll
            for (int m = 0; m < 4; ++m) { const int row = u.pm * 256 + ai * 128 + wr * 64 + m * 16 + fr; const size_t off = (size_t)row * 1024 + col0; float q = 0.f;
#pragma unroll
                for (int bj = 0; bj < 2; ++bj)
#pragma unroll
                    for (int n = 0; n < 2; ++n) { const f32x4 o = *(const f32x4*)(base + off + bj * 128 + n * 16) + acc[ai][bj][m][n];
                        *(f32x4*)(out + off + bj * 128 + n * 16) = o; q += (o[0] * o[0] + o[1] * o[1]) + (o[2] * o[2] + o[3] * o[3]);
                        if (outb) { u32x2 w; w.x = cvtpk(o[0], o[1]); w.y = cvtpk(o[2], o[3]); *(u32x2*)(outb + off + bj * 128 + n * 16) = w; } }
                q += __shfl_xor(q, 16); q += __shfl_xor(q, 32);
                if (fq == 0) atomicAdd(ss + row, q); }
    }
};
struct SchedP5 {
    const char* A; const char* B; int G, c;
    __device__ __forceinline__ bool next(int i, Unit& u) const {
        const int L = i * G + c; if (L >= 64 * 22) return false;
        pg8::tile_order(L, 64, 22, u.pm, u.pn); u.kind = 0; u.A = A + (size_t)u.pm * 256 * 1024 * 2; u.B = B + (size_t)u.pn * 256 * 1024 * 2; return true;
    }
};
struct EpiP5 {
    static constexpr bool PERM = true;
    const float* ss; bf16_t* ACT;
    __device__ __forceinline__ void operator()(const f32x4 (&acc)[2][2][4][2], const Unit& u, int wr, int wc, int fr, int fq) const {
        const int col0 = u.pn * 128 + wc * 32 + 8 * fq;
#pragma unroll
        for (int ai = 0; ai < 2; ++ai)
#pragma unroll
            for (int m = 0; m < 4; ++m) { const int row = u.pm * 256 + ai * 128 + wr * 64 + m * 16 + fr; const float r = __builtin_amdgcn_rsqf(ss[row] * (1.0f / DM) + EPS);
                float o[8];
#pragma unroll
                for (int n = 0; n < 2; ++n)
#pragma unroll
                    for (int i = 0; i < 4; ++i) { const float g = acc[ai][0][m][n][i] * r, up = acc[ai][1][m][n][i] * r; o[4 * n + i] = g * fast_sigmoid(g) * up; }
                u32x4 w; w.x = cvtpk(o[0], o[1]); w.y = cvtpk(o[2], o[3]); w.z = cvtpk(o[4], o[5]); w.w = cvtpk(o[6], o[7]);
                *(u32x4*)(ACT + (size_t)row * DFF + col0) = w; }
    }
};

namespace att {
constexpr int KBYTES = 16384, VBYTES = 16384, TILE_BYTES = KBYTES + VBYTES;
constexpr int FLAG_OFF = 2 * TILE_BYTES;
constexpr int Q_OFF = FLAG_OFF + 64, QP = 272, QW = 32 * QP;
static_assert(Q_OFF % 16 == 0 && Q_OFF + 8 * QW <= 147456, "attention LDS map");
struct TileSrc { const bf16_t* k; const bf16_t* v; unsigned vp; };

__device__ __forceinline__ void tile_dma(const TileSrc& s, LAS unsigned char* buf, int wid, int lane) {
#pragma unroll
    for (int i = 0; i < 2; ++i) {
        const int piece = wid * 2 + i;
        { const int row = piece * 4 + (lane >> 4), cc = (lane & 15) ^ (row & 15); const unsigned off = (unsigned)(row * PROJ_LD + cc * 8);
          __builtin_amdgcn_global_load_lds((const unsigned*)(s.k + off), (LAS unsigned*)(buf + piece * 1024), 16, 0, 0); }
        { const int d = piece * 8 + (lane >> 3), cc = (lane & 7) ^ ((d >> 1) & 7); const unsigned off = (unsigned)d * s.vp + (unsigned)(cc * 8);
          __builtin_amdgcn_global_load_lds((const unsigned*)(s.v + off), (LAS unsigned*)(buf + KBYTES + piece * 1024), 16, 0, 0); }
    }
}
#define ATT_DMA_WAIT() asm volatile("s_waitcnt vmcnt(0)" ::: "memory")
__device__ __forceinline__ int pi32(int r) { return (r & 0x13) | ((r & 4) << 1) | ((r & 8) >> 1); }

struct Ctx {
    const bf16_t* PROJ; bf16_t* PROJW; const bf16_t* VT; const bf16_t* METAK; const bf16_t* METAV;
    const float* subln; float lam;
    LAS unsigned char* lds; int tid, lane, wid, r, h;
};
__device__ __forceinline__ TileSrc tile_src(const Ctx& c, int b, int j, int kcol, int vrow) {
    TileSrc s;
    if (j >= 0) { s.k = c.PROJ + ((size_t)(b * SEQ + 64 * j)) * PROJ_LD + kcol; s.v = c.VT + (size_t)vrow * MROWS + b * SEQ + 64 * j; s.vp = MROWS; }
    else { s.k = c.METAK + kcol; s.v = c.METAV + (size_t)vrow * 64; s.vp = 64; }
    return s;
}
__device__ __forceinline__ int k_addr(int sub, int r, int chunk) { const int row = 32 * sub + pi32(r); return row * 256 + ((chunk ^ (row & 15)) << 4); }
__device__ __forceinline__ int v_addr(int d, int chunk) { return KBYTES + d * 128 + ((chunk ^ ((d >> 1) & 7)) << 4); }

__device__ __forceinline__ void sb_unit(const Ctx& c, int b, int hd, int qb) {
    int lane = c.lane; asm volatile("" : "+v"(lane));
    const int tid = c.tid, r = lane & 31, h = lane >> 5, wid = c.wid;
    const int tq = 256 * qb + 32 * wid + r;
    const size_t qrow = (size_t)(b * SEQ + tq) * PROJ_LD + PC_SBQ + hd * 128;
    bf16x8 qf[8];
#pragma unroll
    for (int ks = 0; ks < 8; ++ks) qf[ks] = *(const bf16x8*)(c.PROJ + qrow + 16 * ks + 8 * h);
    f32x16 o[4];
#pragma unroll
    for (int dt = 0; dt < 4; ++dt) o[dt] = f32x16{};
    float C = 1.0f;
    const int jmax = 4 * qb + 3, NT = jmax + 2;
    const int kcolx = PC_SBK + hd * 128, vrow = hd * 128;
    LAS unsigned* flags = (LAS unsigned*)(c.lds + FLAG_OFF);
    if (tid == 0) { flags[0] = 0u; flags[1] = 0u; flags[2] = 0u; }
    {   const TileSrc s = tile_src(c, b, jmax, kcolx, vrow); tile_dma(s, c.lds, wid, lane); }
    ATT_DMA_WAIT(); __syncthreads();
    const int mydiag = 4 * qb + (wid >> 1);
    bool finished = false;
    for (int t = 0; t < NT; ++t) {
        const int j = (t <= jmax) ? jmax - t : -1;
        const LAS unsigned char* cur = c.lds + (t & 1) * TILE_BYTES;
        const bool more = (t + 1 < NT);
        if (more) { const int jn = (t + 1 <= jmax) ? jmax - (t + 1) : -1; const TileSrc s = tile_src(c, b, jn, kcolx, vrow); tile_dma(s, c.lds + ((t + 1) & 1) * TILE_BYTES, wid, lane); }
        const bool wave_active = (j < 0) || (j <= mydiag);
        if (wave_active && !finished) {
            const int lim = (j >= 0) ? (tq - 64 * j) : NMETA;
#pragma unroll
            for (int sub = 1; sub >= 0; --sub) {
                f32x16 s = f32x16{};
#pragma unroll
                for (int ks = 0; ks < 8; ++ks) { const bf16x8 a = *(const LAS bf16x8*)(cur + k_addr(sub, r, 2 * ks + h)); s = __builtin_amdgcn_mfma_f32_32x32x16_bf16(a, qf[ks], s, 0, 0, 0); }
                float av[16], fv[16];
#pragma unroll
                for (int reg = 0; reg < 16; ++reg) {
                    const int kap = 32 * sub + 16 * (reg >> 3) + 8 * h + (reg & 7);
                    const float z = __builtin_fminf(__builtin_fmaxf(s[reg], -115.f), 115.f);
                    const float e = __builtin_amdgcn_exp2f(-z); const float beta = __builtin_amdgcn_rcpf(1.0f + e); const float f = e * beta;
                    const bool valid = kap < lim; av[reg] = valid ? beta : 0.f; fv[reg] = valid ? f : 1.f;
                }
                float run = 1.f;
#pragma unroll
                for (int reg = 15; reg >= 8; --reg) { av[reg] *= run; run *= fv[reg]; }
                const float GU = run; run = 1.f;
#pragma unroll
                for (int reg = 7; reg >= 0; --reg) { av[reg] *= run; run *= fv[reg]; }
                const float GL = run;
                const float GUo = __shfl_xor(GU, 32), GLo = __shfl_xor(GL, 32);
                const float pU = GU * GUo, pL = GL * GLo;
                const float preU = h ? C : C * GUo, preL = h ? C * pU : (C * pU) * GLo;
                C = C * (pU * pL);
                u32x4 pf0, pf1;
                pf0.x = cvtpk(av[0] * preL, av[1] * preL); pf0.y = cvtpk(av[2] * preL, av[3] * preL); pf0.z = cvtpk(av[4] * preL, av[5] * preL); pf0.w = cvtpk(av[6] * preL, av[7] * preL);
                pf1.x = cvtpk(av[8] * preU, av[9] * preU); pf1.y = cvtpk(av[10] * preU, av[11] * preU); pf1.z = cvtpk(av[12] * preU, av[13] * preU); pf1.w = cvtpk(av[14] * preU, av[15] * preU);
                const bf16x8 p0 = __builtin_bit_cast(bf16x8, pf0), p1 = __builtin_bit_cast(bf16x8, pf1);
#pragma unroll
                for (int dt = 0; dt < 4; ++dt) {
                    const bf16x8 v0 = *(const LAS bf16x8*)(cur + v_addr(32 * dt + r, 4 * sub + h));
                    const bf16x8 v1 = *(const LAS bf16x8*)(cur + v_addr(32 * dt + r, 4 * sub + 2 + h));
                    o[dt] = __builtin_amdgcn_mfma_f32_32x32x16_bf16(v0, p0, o[dt], 0, 0, 0);
                    o[dt] = __builtin_amdgcn_mfma_f32_32x32x16_bf16(v1, p1, o[dt], 0, 0, 0);
                }
            }
            finished = __all(C < 1e-20f);
        }
#if SB_EARLY_EXIT
        const int fw = t % 3;
        if (!finished && lane == 0) flags[fw] = 1u;
        ATT_DMA_WAIT(); __syncthreads();
        const unsigned any_live = flags[fw];
        if (tid == 0) flags[(fw + 2) % 3] = 0u;
        if (!any_live) break;
#else
        ATT_DMA_WAIT(); __syncthreads();
#endif
    }
    bf16_t* orow = c.PROJW + qrow;
#pragma unroll
    for (int dt = 0; dt < 4; ++dt)
#pragma unroll
        for (int g = 0; g < 4; ++g) { u32x2 w; w.x = cvtpk(o[dt][4 * g], o[dt][4 * g + 1]); w.y = cvtpk(o[dt][4 * g + 2], o[dt][4 * g + 3]); *(u32x2*)(orow + 32 * dt + 8 * g + 4 * h) = w; }
}

__device__ __forceinline__ void df_unit(const Ctx& c, int b, int hd, int qb) {
    int lane = c.lane; asm volatile("" : "+v"(lane));
    const int r = lane & 31, h = lane >> 5, wid = c.wid;
    const int tq = 256 * qb + 32 * wid + r;
    const size_t qrow = (size_t)(b * SEQ + tq) * PROJ_LD + PC_DFQ + hd * 128;
    LAS unsigned char* qw = c.lds + Q_OFF + wid * QW;
    {   const size_t qbase = (size_t)(b * SEQ + 256 * qb + 32 * wid) * PROJ_LD + PC_DFQ + hd * 128;
#pragma unroll
        for (int i = 0; i < 8; ++i) { const int row = 4 * i + (lane >> 4), ch = lane & 15; const u32x4 v = *(const u32x4*)(c.PROJ + qbase + (size_t)row * PROJ_LD + ch * 8); *(LAS u32x4*)(qw + row * QP + ch * 16) = v; } }
    f32x16 o[2][4];
#pragma unroll
    for (int cm = 0; cm < 2; ++cm)
#pragma unroll
        for (int dt = 0; dt < 4; ++dt) o[cm][dt] = f32x16{};
    float mref[2] = {-INFINITY, -INFINITY}, lsum[2] = {0.f, 0.f};
    const float sl2 = __builtin_amdgcn_exp2f(-(float)(hd + 1)) * LOG2E;
    const int jmax = 4 * qb + 3, NT = jmax + 2;
    const int kcolx = PC_DFK + hd * 128, vrow = 1024 + hd * 128;
    {   const TileSrc s = tile_src(c, b, jmax, kcolx, vrow); tile_dma(s, c.lds, wid, lane); }
    ATT_DMA_WAIT(); __syncthreads();
    const int mychunk = 4 * qb + (wid >> 1);
    const LAS unsigned char* qfp = qw + r * QP + 16 * h;
    for (int t = 0; t < NT; ++t) {
        const int j = (t <= jmax) ? jmax - t : -1;
        const LAS unsigned char* cur = c.lds + (t & 1) * TILE_BYTES;
        const bool more = (t + 1 < NT);
        if (more) { const int jn = (t + 1 <= jmax) ? jmax - (t + 1) : -1; const TileSrc s = tile_src(c, b, jn, kcolx, vrow); tile_dma(s, c.lds + ((t + 1) & 1) * TILE_BYTES, wid, lane); }
        if (j < 0 || j <= mychunk) {
            const float tqf = (float)(j >= 0 ? tq - 64 * j : tq + NMETA);
            const bool meta = (j < 0);
#pragma unroll 1
            for (int sub = 1; sub >= 0; --sub) {
                u32x4 pf[2][2];
#pragma unroll
                for (int cm = 0; cm < 2; ++cm) {
                    f32x16 s = f32x16{};
#pragma unroll
                    for (int ks = 0; ks < 4; ++ks) { const bf16x8 a = *(const LAS bf16x8*)(cur + k_addr(sub, r, 8 * cm + 2 * ks + h)); const bf16x8 q = *(const LAS bf16x8*)(qfp + cm * 128 + ks * 32);
                        s = __builtin_amdgcn_mfma_f32_32x32x16_bf16(a, q, s, 0, 0, 0); }
                    float mx = -INFINITY;
#pragma unroll
                    for (int reg = 0; reg < 16; ++reg) {
                        const int kap = 32 * sub + 16 * (reg >> 3) + 8 * h + (reg & 7);
                        float v = __builtin_fmaf(-sl2, __builtin_fabsf(tqf - (float)kap), s[reg]);
                        if (meta && kap >= NMETA) v = -1e30f;
                        s[reg] = v; mx = __builtin_fmaxf(mx, v);
                    }
                    mx = __builtin_fmaxf(mx, __shfl_xor(mx, 32));
                    if (__any(mx > mref[cm] + 8.0f)) {
                        const float mnew = __builtin_fmaxf(mref[cm], mx), sc = __builtin_amdgcn_exp2f(mref[cm] - mnew);
                        lsum[cm] *= sc; mref[cm] = mnew;
#pragma unroll
                        for (int dt = 0; dt < 4; ++dt) o[cm][dt] *= sc;
                    }
                    float ps = 0.f;
#pragma unroll
                    for (int reg = 0; reg < 16; ++reg) { const float p = __builtin_amdgcn_exp2f(s[reg] - mref[cm]); s[reg] = p; ps += p; }
                    lsum[cm] += ps;
                    pf[cm][0].x = cvtpk(s[0], s[1]); pf[cm][0].y = cvtpk(s[2], s[3]); pf[cm][0].z = cvtpk(s[4], s[5]); pf[cm][0].w = cvtpk(s[6], s[7]);
                    pf[cm][1].x = cvtpk(s[8], s[9]); pf[cm][1].y = cvtpk(s[10], s[11]); pf[cm][1].z = cvtpk(s[12], s[13]); pf[cm][1].w = cvtpk(s[14], s[15]);
                    __builtin_amdgcn_sched_barrier(0);
                }
#pragma unroll
                for (int dt = 0; dt < 4; ++dt) {
                    const bf16x8 v0 = *(const LAS bf16x8*)(cur + v_addr(32 * dt + r, 4 * sub + h));
                    const bf16x8 v1 = *(const LAS bf16x8*)(cur + v_addr(32 * dt + r, 4 * sub + 2 + h));
#pragma unroll
                    for (int cm = 0; cm < 2; ++cm) {
                        o[cm][dt] = __builtin_amdgcn_mfma_f32_32x32x16_bf16(v0, __builtin_bit_cast(bf16x8, pf[cm][0]), o[cm][dt], 0, 0, 0);
                        o[cm][dt] = __builtin_amdgcn_mfma_f32_32x32x16_bf16(v1, __builtin_bit_cast(bf16x8, pf[cm][1]), o[cm][dt], 0, 0, 0);
                    }
                }
            }
        }
        ATT_DMA_WAIT(); __syncthreads();
    }
    const float L0 = lsum[0] + __shfl_xor(lsum[0], 32), L1 = lsum[1] + __shfl_xor(lsum[1], 32);
    const float i0 = 1.0f / L0, i1 = c.lam / L1;
    float ss = 0.f;
#pragma unroll
    for (int dt = 0; dt < 4; ++dt)
#pragma unroll
        for (int reg = 0; reg < 16; ++reg) { const float v = o[0][dt][reg] * i0 - o[1][dt][reg] * i1; o[0][dt][reg] = v; ss += v * v; }
    ss += __shfl_xor(ss, 32);
    __builtin_amdgcn_sched_barrier(0);
    const float rs = __builtin_amdgcn_rsqf(ss * (1.0f / 128.0f) + EPS) * 0.8f;
    bf16_t* orow = c.PROJW + qrow;
#pragma unroll
    for (int dt = 0; dt < 4; ++dt)
#pragma unroll
        for (int g = 0; g < 4; ++g) { const int d0 = 32 * dt + 8 * g + 4 * h; const f32x4 gn = *(const f32x4*)(c.subln + d0);
            u32x2 w; w.x = cvtpk(o[0][dt][4 * g] * rs * gn[0], o[0][dt][4 * g + 1] * rs * gn[1]); w.y = cvtpk(o[0][dt][4 * g + 2] * rs * gn[2], o[0][dt][4 * g + 3] * rs * gn[3]);
            *(u32x2*)(orow + d0) = w; }
}
}

__device__ __forceinline__ void transpose_item(const float* W, int ldw, int k0, int n0, bf16_t* WT, int ldwt, int drow0, int dcol0, int dup_off, float scale, const float* kscale, LAS float* scr, int lane) {
#pragma unroll 8
    for (int i = 0; i < 32; ++i) { const int kk = 2 * i + (lane >> 5); float v = W[(size_t)(k0 + kk) * ldw + n0 + (lane & 31)] * scale; if (kscale) v *= kscale[k0 + kk]; scr[kk * 33 + (lane & 31)] = v; }
    asm volatile("s_waitcnt lgkmcnt(0)" ::: "memory");
    const int cc = lane & 7;
#pragma unroll
    for (int jj = 0; jj < 4; ++jj) { const int n = (lane >> 3) + 8 * jj; const LAS float* s = scr + (8 * cc) * 33 + n;
        u32x4 ov; ov.x = cvtpk(s[0 * 33], s[1 * 33]); ov.y = cvtpk(s[2 * 33], s[3 * 33]); ov.z = cvtpk(s[4 * 33], s[5 * 33]); ov.w = cvtpk(s[6 * 33], s[7 * 33]);
        bf16_t* dst = WT + (size_t)(drow0 + n) * ldwt + dcol0 + k0 + 8 * cc;
        *(u32x4*)dst = ov; if (dup_off) *(u32x4*)(dst + dup_off) = ov; }
    asm volatile("s_waitcnt lgkmcnt(0)" ::: "memory");
}

struct Args { const float* in[19]; float* out; unsigned char* ws; int ph_lo, ph_hi; };

__global__ void __launch_bounds__(NTHREADS, 2) fwd_kernel(Args args) {
    extern __shared__ __attribute__((aligned(16))) unsigned char lds_raw[];
    LAS unsigned char* lds = (LAS unsigned char*)lds_raw;
    const int tid = threadIdx.x, lane = tid & 63, wid = __builtin_amdgcn_readfirstlane(tid >> 6);
    const int G = gridDim.x, bx = blockIdx.x;
    unsigned char* ws = args.ws;
    const float* x = args.in[0];
    bf16_t* W1T = (bf16_t*)(ws + WS_W1T); bf16_t* XN = (bf16_t*)(ws + WS_XN); bf16_t* PROJ = (bf16_t*)(ws + WS_PROJ); bf16_t* GATES = (bf16_t*)(ws + WS_GATES);
    bf16_t* METAK = (bf16_t*)(ws + WS_METAK); bf16_t* METAV = (bf16_t*)(ws + WS_METAV);
    bf16_t* WBR = (bf16_t*)(ws + WS_WBR); bf16_t* WOUT2 = (bf16_t*)(ws + WS_WOUT2); bf16_t* WFFN = (bf16_t*)(ws + WS_WFFN); bf16_t* WDOWN = (bf16_t*)(ws + WS_WDOWN);
    bf16_t* H1B = (bf16_t*)(ws + WS_H1B); bf16_t* ACT = (bf16_t*)(ws + WS_ACT); float* H1 = (float*)(ws + WS_H1);
    float* SS1 = (float*)(ws + CTL_SS1); float* SS2 = (float*)(ws + CTL_SS2);
    bf16_t* VT = (bf16_t*)args.out; bf16_t* Y = (bf16_t*)args.out;
    const int gw = bx * NWAVES + wid, NGW = G * NWAVES;
    const int lo = args.ph_lo, hi = args.ph_hi;
#define IN(k) (lo <= (k) && (k) < hi)
#if MK_N_LAUNCHES == 1
#define GRID_BAR() cg::this_grid().sync()
#else
#define GRID_BAR() do {} while (0)
#endif

    if (IN(0)) {
        LAS float* scr = (LAS float*)(lds + wid * 16384);
        const float* w_in = args.in[3]; const float* w_gate = args.in[4];
        const float cq_sb = LOG2E * 0.08838834764831845f, cq_df = LOG2E * 0.125f;
        for (int it = gw; it < 16 * 256; it += NGW) {
            const int kb = it >> 8, nb = it & 255, blk = nb >> 5, nin = (nb & 31) * 32;
            const float* src; int ldw, n0; float sc = 1.f;
            switch (blk) {
                case 0: src = w_in; ldw = 6144; n0 = 0 + nin; sc = cq_sb; break;
                case 1: src = w_in; ldw = 6144; n0 = 1024 + nin; break;
                case 2: src = w_in; ldw = 6144; n0 = 3072 + nin; sc = cq_df; break;
                case 3: src = w_in; ldw = 6144; n0 = 4096 + nin; break;
                case 4: src = w_gate; ldw = 2048; n0 = nin; break;
                case 5: src = w_gate; ldw = 2048; n0 = 1024 + nin; break;
                case 6: src = w_in; ldw = 6144; n0 = 2048 + nin; break;
                default: src = w_in; ldw = 6144; n0 = 5120 + nin; break;
            }
            transpose_item(src, ldw, kb * 64, n0, W1T, 1024, nb * 32, 0, 0, sc, nullptr, scr, lane);
        }
        {   const float* g = args.in[2];
            f32x4 gv[4];
#pragma unroll
            for (int jj = 0; jj < 4; ++jj) gv[jj] = *((const f32x4*)g + lane + 64 * jj);
            for (int m = gw; m < MROWS; m += NGW) {
                const f32x4* xr = (const f32x4*)(x + (size_t)m * DM) + lane; f32x4 v[4]; float s = 0.f;
#pragma unroll
                for (int jj = 0; jj < 4; ++jj) { v[jj] = xr[64 * jj]; s += (v[jj].x * v[jj].x + v[jj].y * v[jj].y) + (v[jj].z * v[jj].z + v[jj].w * v[jj].w); }
                const float rstd = __builtin_amdgcn_rsqf(wave_sum(s) * (1.0f / DM) + EPS);
                u32x2* o8 = (u32x2*)(XN + (size_t)m * DM) + lane;
#pragma unroll
                for (int jj = 0; jj < 4; ++jj) { u32x2 w; w.x = cvtpk(v[jj].x * rstd * gv[jj].x, v[jj].y * rstd * gv[jj].y); w.y = cvtpk(v[jj].z * rstd * gv[jj].z, v[jj].w * rstd * gv[jj].w); o8[64 * jj] = w; }
            }
        }
        if (bx < 32) {
            __syncthreads();
            LAS float* xm = (LAS float*)lds;
            LAS float* part = (LAS float*)(lds + 65536);
            const float* meta = args.in[1]; const float* g = args.in[2];
            for (int rr = 0; rr < 2; ++rr) { const int row = 2 * wid + rr; const f32x4* xr = (const f32x4*)(meta + (size_t)row * DM) + lane; f32x4 v[4]; float s = 0.f;
#pragma unroll
                for (int jj = 0; jj < 4; ++jj) { v[jj] = xr[64 * jj]; s += (v[jj].x * v[jj].x + v[jj].y * v[jj].y) + (v[jj].z * v[jj].z + v[jj].w * v[jj].w); }
                const float rstd = __builtin_amdgcn_rsqf(wave_sum(s) * (1.0f / DM) + EPS);
#pragma unroll
                for (int jj = 0; jj < 4; ++jj) { const f32x4 gg = *((const f32x4*)g + lane + 64 * jj); f32x4 w = v[jj] * rstd * gg; *(LAS f32x4*)(xm + row * 1024 + 4 * (lane + 64 * jj)) = w; } }
            __syncthreads();
            const int cl = tid & 127, kq = tid >> 7, blk = bx >> 3, col = (bx & 7) * 128 + cl;
            const int srcc = (blk == 0 ? 1024 : blk == 1 ? 2048 : blk == 2 ? 4096 : 5120) + col;
            float acc[16];
#pragma unroll
            for (int i = 0; i < 16; ++i) acc[i] = 0.f;
            for (int k = kq * 256; k < kq * 256 + 256; ++k) { const float w = w_in[(size_t)k * 6144 + srcc];
#pragma unroll
                for (int i = 0; i < 16; ++i) acc[i] = __builtin_fmaf(xm[i * 1024 + k], w, acc[i]); }
#pragma unroll
            for (int i = 0; i < 16; ++i) part[(kq * 16 + i) * 128 + cl] = acc[i];
            __syncthreads();
            if (blk == 0 || blk == 2) {
                const int row = tid >> 5, c4 = (tid & 31) * 4; float v[4];
#pragma unroll
                for (int i = 0; i < 4; ++i) v[i] = (part[(0 * 16 + row) * 128 + c4 + i] + part[(1 * 16 + row) * 128 + c4 + i]) + (part[(2 * 16 + row) * 128 + c4 + i] + part[(3 * 16 + row) * 128 + c4 + i]);
                const int dcol = (blk == 2 ? PC_DFK : PC_SBK) + (bx & 7) * 128 + c4;
                u32x2 w; w.x = cvtpk(v[0], v[1]); w.y = cvtpk(v[2], v[3]); *(u32x2*)(METAK + (size_t)row * PROJ_LD + dcol) = w;
                const u32x2 z = {0u, 0u};
#pragma unroll
                for (int i = 0; i < 3; ++i) *(u32x2*)(METAK + (size_t)(16 + row + 16 * i) * PROJ_LD + dcol) = z;
            } else if (tid < 128) {
                float v[16];
#pragma unroll
                for (int i = 0; i < 16; ++i) v[i] = (part[(0 * 16 + i) * 128 + cl] + part[(1 * 16 + i) * 128 + cl]) + (part[(2 * 16 + i) * 128 + cl] + part[(3 * 16 + i) * 128 + cl]);
                bf16_t* dst = METAV + (size_t)((blk == 3 ? 1024 : 0) + col) * 64;
                u32x4 w0, w1; const u32x4 z = {0u, 0u, 0u, 0u};
                w0.x = cvtpk(v[0], v[1]); w0.y = cvtpk(v[2], v[3]); w0.z = cvtpk(v[4], v[5]); w0.w = cvtpk(v[6], v[7]);
                w1.x = cvtpk(v[8], v[9]); w1.y = cvtpk(v[10], v[11]); w1.z = cvtpk(v[12], v[13]); w1.w = cvtpk(v[14], v[15]);
                *(u32x4*)(dst) = w0; *(u32x4*)(dst + 8) = w1;
#pragma unroll
                for (int i = 2; i < 8; ++i) *(u32x4*)(dst + 8 * i) = z;
            }
        }
        if (IN(1)) GRID_BAR();
    }

    if (IN(1)) {
        SchedP1 S{(const char*)XN, (const char*)W1T, G, bx};
        EpiP1 E{PROJ, GATES, VT, args.in[5]};
        pg8::gemm_phase<EpiP1, SchedP1, true>(lds, 1024, 1024, 1024, S, E);
        if (IN(2)) GRID_BAR();
    }

    if (IN(2)) {
        {   LAS float* scr = (LAS float*)(lds + wid * 16384);
            const float* w_br_sb = args.in[11]; const float* w_br_df = args.in[12]; const float* w_out = args.in[13]; const float* gffn = args.in[14];
            const float* w_fg = args.in[15]; const float* w_fu = args.in[16]; const float* w_fd = args.in[17];
            constexpr int I_BR = 16 * 32, I_FFN = 16 * 176, I_DN = 44 * 32, I_ALL = 3 * I_BR + I_FFN + I_DN;
            for (int it0 = gw; it0 < I_ALL; it0 += NGW) {
                int it = it0;
                if (it < I_BR) { transpose_item(w_br_sb, 1024, (it >> 5) * 64, (it & 31) * 32, WBR, 1024, (it & 31) * 32, 0, 0, 1.f, nullptr, scr, lane); continue; } it -= I_BR;
                if (it < I_BR) { transpose_item(w_br_df, 1024, (it >> 5) * 64, (it & 31) * 32, WBR, 1024, 1024 + (it & 31) * 32, 0, 0, 1.f, nullptr, scr, lane); continue; } it -= I_BR;
                if (it < I_BR) { transpose_item(w_out, 1024, (it >> 5) * 64, (it & 31) * 32, WOUT2, 2048, (it & 31) * 32, 0, 1024, 1.f, nullptr, scr, lane); continue; } it -= I_BR;
                if (it < I_FFN) { const int kb = it / 176, nb = it % 176, R = nb * 32, p = R >> 8, rr = R & 255;
                    const float* src = (rr < 128) ? w_fg : w_fu; const int n0 = 128 * p + (rr & 127);
                    transpose_item(src, DFF, kb * 64, n0, WFFN, 1024, R, 0, 0, 1.f, gffn, scr, lane); continue; } it -= I_FFN;
                transpose_item(w_fd, 1024, (it >> 5) * 64, (it & 31) * 32, WDOWN, DFF, (it & 31) * 32, 0, 0, 1.f, nullptr, scr, lane);
            }
        }
        __syncthreads();
        att::Ctx c; c.PROJ = PROJ; c.PROJW = PROJ; c.VT = VT; c.METAK = METAK; c.METAV = METAV; c.subln = args.in[10]; c.lds = lds; c.tid = tid; c.lane = lane; c.wid = wid; c.r = lane & 31; c.h = lane >> 5;
        {   const float a1 = args.in[6][lane] * args.in[7][lane], a2 = args.in[8][lane] * args.in[9][lane];
            c.lam = __expf(wave_sum(a1)) - __expf(wave_sum(a2)) + 0.2f; }
        LAS unsigned* flags = (LAS unsigned*)(lds + att::FLAG_OFF);
        if (tid < 8) flags[tid] = 0u;
        __syncthreads();
        unsigned* queue = (unsigned*)(ws + CTL_QUEUE);
        for (;;) {
            if (tid == 0) flags[4] = atomicAdd(queue, 1u);
            __syncthreads();
            const unsigned u = flags[4];
            __syncthreads();
            if (u >= 1024u) break;
            if (u < 512u) {
#ifndef NO_DF
                const int qb = 31 - (int)(u >> 4), hb = (int)(u & 15), hd = 7 - (hb >> 1), b = hb & 1; att::df_unit(c, b, hd, qb);
#endif
            }
            else {
#ifndef NO_SB
                const unsigned v = u - 512u; const int qb = 31 - (int)(v >> 4), hb = (int)(v & 15), hd = hb >> 1, b = hb & 1; att::sb_unit(c, b, hd, qb);
#endif
            }
        }
        if (IN(3)) GRID_BAR();
    }

    if (IN(3)) {
        SchedP3 S{(const char*)PROJ, (const char*)WBR, G, bx};
        EpiP3 E{GATES, Y};
        pg8::gemm_phase<EpiP3, SchedP3, true>(lds, 1024, PROJ_LD, 1024, S, E);
        if (IN(4)) GRID_BAR();
    }

    if (IN(4)) {
        SchedN1024 S{(const char*)Y, (const char*)WOUT2, (size_t)2048 * 2, (size_t)2048 * 2, G, bx};
        EpiRes E{x, H1, H1B, SS1};
        pg8::gemm_phase<EpiRes, SchedN1024, false>(lds, 2048, 2048, 2048, S, E);
        if (IN(5)) GRID_BAR();
    }

    if (IN(5)) {
        SchedP5 S{(const char*)H1B, (const char*)WFFN, G, bx};
        EpiP5 E{SS1, ACT};
        pg8::gemm_phase<EpiP5, SchedP5, true>(lds, 1024, 1024, 1024, S, E);
        if (IN(6)) GRID_BAR();
    }

    if (IN(6)) {
        SchedN1024 S{(const char*)ACT, (const char*)WDOWN, (size_t)DFF * 2, (size_t)DFF * 2, G, bx};
        EpiRes E{H1, args.out, nullptr, SS2};
        pg8::gemm_phase<EpiRes, SchedN1024, false>(lds, DFF, DFF, DFF, S, E);
        if (IN(7)) GRID_BAR();
    }

    if (IN(7)) {
        const float* g = args.in[18];
        f32x4 gv[4];
#pragma unroll
        for (int jj = 0; jj < 4; ++jj) gv[jj] = *((const f32x4*)g + lane + 64 * jj);
        for (int m = gw; m < MROWS; m += NGW) {
            f32x4* xr = (f32x4*)(args.out + (size_t)m * DM) + lane; const float rstd = __builtin_amdgcn_rsqf(SS2[m] * (1.0f / DM) + EPS);
#pragma unroll
            for (int jj = 0; jj < 4; ++jj) { f32x4 v = xr[64 * jj]; v = v * rstd * gv[jj]; xr[64 * jj] = v; }
        }
    }
#undef IN
}

constexpr int LDS_BYTES = 147456;
extern "C" void kernel_launch(void* const* d_in, const int* in_sizes, int n_in, void* d_out, int out_size, void* d_ws, size_t ws_size, hipStream_t stream) {
    static int grid = 0;
    if (grid == 0) {
        if (n_in != 19 || out_size != MROWS * DM || ws_size < WS_END) { fprintf(stderr, "kernel_launch: unexpected shapes (n_in %d out %d ws %zu)\n", n_in, out_size, ws_size); grid = -1; return; }
        int dev = 0, cus = 0, per_cu = 0;
        hipGetDevice(&dev); hipDeviceGetAttribute(&cus, hipDeviceAttributeMultiprocessorCount, dev);
        if (hipFuncSetAttribute((const void*)fwd_kernel, hipFuncAttributeMaxDynamicSharedMemorySize, LDS_BYTES) != hipSuccess) { fprintf(stderr, "kernel_launch: hipFuncSetAttribute failed\n"); grid = -1; return; }
        if (hipOccupancyMaxActiveBlocksPerMultiprocessor(&per_cu, (const void*)fwd_kernel, NTHREADS, LDS_BYTES) != hipSuccess || per_cu < 1) { fprintf(stderr, "kernel_launch: occupancy query says %d\n", per_cu); per_cu = 1; }
        (void)hipGetLastError();
        grid = cus * 1;
    }
    if (grid < 0) return;
    (void)hipMemsetAsync((char*)d_ws + WS_CTL, 0, CTL_BYTES, stream);
    Args a{};
    for (int i = 0; i < 19; ++i) a.in[i] = (const float*)d_in[i];
    a.out = (float*)d_out; a.ws = (unsigned char*)d_ws;
#if MK_N_LAUNCHES == 1
    a.ph_lo = 0; a.ph_hi = 8;
    void* kargs[] = {&a};
    hipError_t e = hipLaunchCooperativeKernel((const void*)fwd_kernel, dim3(grid), dim3(NTHREADS), kargs, LDS_BYTES, stream);
    if (e != hipSuccess) fprintf(stderr, "kernel_launch: cooperative launch failed: %s (grid %d)\n", hipGetErrorString(e), grid);
#else
    for (int p = 0; p < 8; ++p) { a.ph_lo = p; a.ph_hi = p + 1; hipLaunchKernelGGL(fwd_kernel, dim3(grid), dim3(NTHREADS), LDS_BYTES, stream, a); }
#endif
}
```

```cpp
#include <hip/hip_runtime.h>
#include <hip/hip_cooperative_groups.h>
#include <cstdio>
#include <cstdint>
namespace cg = cooperative_groups;

#ifndef MK_N_LAUNCHES
#define MK_N_LAUNCHES 1
#endif
#ifndef SB_EARLY_EXIT
#define SB_EARLY_EXIT 1
#endif

#define LAS __attribute__((address_space(3)))
typedef unsigned short bf16_t;
typedef short bf16x8 __attribute__((ext_vector_type(8)));
typedef float f32x4 __attribute__((ext_vector_type(4)));
typedef float f32x16 __attribute__((ext_vector_type(16)));
typedef unsigned u32x4 __attribute__((ext_vector_type(4)));
typedef unsigned u32x2 __attribute__((ext_vector_type(2)));
typedef float f32x2_t __attribute__((ext_vector_type(2)));
typedef __bf16 bf16x2_t __attribute__((ext_vector_type(2)));

constexpr int SEQ = 8192, DM = 1024, MROWS = 2 * SEQ, NMETA = 16, DFF = 2816;
constexpr float EPS = 1e-6f;
constexpr float LOG2E = 1.4426950408889634f;
constexpr int NWAVES = 8, NTHREADS = 512;
constexpr int PROJ_LD = 4096;
constexpr int PC_SBQ = 0, PC_SBK = 1024, PC_DFQ = 2048, PC_DFK = 3072;

constexpr size_t MiB = 1u << 20;
constexpr size_t WS_CTL = 0, CTL_BYTES = 1 * MiB;
constexpr size_t CTL_QUEUE = 256;
constexpr size_t CTL_SS1 = 256 * 1024, CTL_SS2 = 512 * 1024;
constexpr size_t WS_W1T = 1 * MiB;
constexpr size_t WS_METAK = 17 * MiB;
constexpr size_t WS_METAV = WS_METAK + 512 * 1024;
constexpr size_t WS_XN = 18 * MiB;
constexpr size_t WS_WBR = 18 * MiB;
constexpr size_t WS_WOUT2 = 22 * MiB;
constexpr size_t WS_WFFN = 26 * MiB;
constexpr size_t WS_WDOWN = 38 * MiB;
constexpr size_t WS_PROJ = 50 * MiB;
constexpr size_t WS_H1B = 50 * MiB;
constexpr size_t WS_ACT = 82 * MiB;
constexpr size_t WS_GATES = 178 * MiB;
constexpr size_t WS_H1 = 178 * MiB;
constexpr size_t WS_END = 242 * MiB;

__device__ __forceinline__ unsigned cvtpk(float lo, float hi) { f32x2_t v = {lo, hi}; bf16x2_t b = __builtin_convertvector(v, bf16x2_t); return __builtin_bit_cast(unsigned, b); }
__device__ __forceinline__ float bf2f(unsigned short b) { return __builtin_bit_cast(float, (unsigned)b << 16); }
__device__ __forceinline__ float wave_sum(float v) {
#pragma unroll
    for (int o = 1; o < 64; o <<= 1) v += __shfl_xor(v, o);
    return v;
}
__device__ __forceinline__ float fast_sigmoid(float x) { return __builtin_amdgcn_rcpf(1.0f + __builtin_amdgcn_exp2f(-x * LOG2E)); }

namespace pg8 {
constexpr int BM = 256, BK = 64, HALF = 128, HTB = HALF * BK * 2, STAGE_BYTES = 8 * HTB, NXCD = 8, WGM = 8;
__host__ __device__ __forceinline__ int lds_byte(int r, int c) { const int st = (r >> 4) * 2 + (c >> 5), rr = r & 15, cc = c & 31, ob = rr * 64 + cc * 2; return st * 1024 + (ob ^ (((ob >> 9) & 1) << 5)); }
__host__ __device__ __forceinline__ void stage_rc(int b, int& R, int& C) { const int st = b / 1024, sb = b % 1024, swz = sb ^ (((sb >> 9) & 1) << 5); R = (st >> 1) * 16 + swz / 64; C = (st & 1) * 32 + (swz % 64) / 2; }
__host__ __device__ __forceinline__ int perm32(int rho) { const int n = rho >> 4, i = rho & 15; return 8 * (i >> 2) + 4 * n + (i & 3); }

struct Unit { int pm, pn, kind; const char* A; const char* B; };
__device__ __forceinline__ void tile_order(int wgid, int nM, int nN, int& pm, int& pn) {
    const int nwg = nM * nN;
    { const int q = nwg / NXCD, r = nwg % NXCD, xcd = wgid % NXCD, off = wgid / NXCD; wgid = (xcd < r ? xcd * (q + 1) : r * (q + 1) + (xcd - r) * q) + off; }
    const int nig = WGM * nN, gid = wgid / nig, fm = gid * WGM, gsz = (nM - fm) < WGM ? (nM - fm) : WGM;
    pm = fm + ((wgid % nig) % gsz); pn = (wgid % nig) / gsz;
}
template <class Epi, class Sched, bool ALIGN_EPI>
__device__ __forceinline__ void gemm_phase(LAS unsigned char* lds, const int K, const int lda, const int ldb, const Sched& S, const Epi& E) {
    const int tid = threadIdx.x, wid = __builtin_amdgcn_readfirstlane(tid >> 6), lane = tid & 63, wr = wid >> 2, wc = wid & 3, fr = lane & 15, fq = lane >> 4;
    const int nt = K / BK;
    unsigned voffA[2], voffB[2];
#pragma unroll
    for (int i = 0; i < 2; ++i) { int R, C; stage_rc(tid * 16 + i * 8192, R, C); const int Rb = Epi::PERM ? ((R & ~31) + perm32(R & 31)) : R;
        voffA[i] = (unsigned)(R * lda + C) * 2u; voffB[i] = (unsigned)(Rb * ldb + C) * 2u; }
    const size_t kstep = (size_t)(BK * 2);
    const size_t hstepA = (size_t)HALF * lda * 2, hstepB = (size_t)HALF * ldb * 2;
    const unsigned ldsw = (unsigned)wid * 1024u;
    const int aoff = lds_byte(wr * 64 + fr, fq * 8), boff = lds_byte(wc * 32 + fr, fq * 8);
#define PG8_SA(b, h) (((b) * 2 + (h)) * HTB)
#define PG8_SB(b, h) ((4 + (b) * 2 + (h)) * HTB)
#define PG8_STAGE(bufoff, gbase, voff) do { _Pragma("unroll") for (int _i = 0; _i < 2; ++_i) \
        __builtin_amdgcn_global_load_lds((const unsigned*)((const char*)(gbase) + (voff)[_i]), (LAS unsigned*)(lds + (bufoff) + ldsw + _i * 8192), 16, 0, 0); } while (0)
#define PG8_LDA(dst, b, h) do { _Pragma("unroll") for (int m = 0; m < 4; ++m) _Pragma("unroll") for (int k = 0; k < 2; ++k) dst[m][k] = *(const LAS bf16x8*)(lds + PG8_SA(b, h) + aoff + m * 2048 + k * 1024); } while (0)
#define PG8_LDB(dst, b, h) do { _Pragma("unroll") for (int n = 0; n < 2; ++n) _Pragma("unroll") for (int k = 0; k < 2; ++k) dst[n][k] = *(const LAS bf16x8*)(lds + PG8_SB(b, h) + boff + n * 2048 + k * 1024); } while (0)
#define PG8_MMA(ai, bj, At, Bt) do { __builtin_amdgcn_s_setprio(1); _Pragma("unroll") for (int m = 0; m < 4; ++m) _Pragma("unroll") for (int n = 0; n < 2; ++n) _Pragma("unroll") for (int k = 0; k < 2; ++k) \
        acc[ai][bj][m][n] = __builtin_amdgcn_mfma_f32_16x16x32_bf16(Bt[n][k], At[m][k], acc[ai][bj][m][n], 0, 0, 0); __builtin_amdgcn_s_setprio(0); } while (0)
#define PG8_WAIT_V(n) asm volatile("s_waitcnt vmcnt(" #n ")" ::: "memory")
#define PG8_WAIT_L(n) asm volatile("s_waitcnt lgkmcnt(" #n ")" ::: "memory")
#define PG8_BAR __builtin_amdgcn_s_barrier()
#define PG8_SCHED __builtin_amdgcn_sched_barrier(0)
    Unit cur, nxt; int ui = 0;
    if (!S.next(0, cur)) return;
    f32x4 acc[2][2][4][2];
#pragma unroll
    for (int a = 0; a < 2; ++a)
#pragma unroll
        for (int b = 0; b < 2; ++b)
#pragma unroll
            for (int m = 0; m < 4; ++m)
#pragma unroll
                for (int n = 0; n < 2; ++n) acc[a][b][m][n] = (f32x4){0.f, 0.f, 0.f, 0.f};
    bf16x8 At[4][2], B0[2][2], B1[2][2];
    const char* cA = cur.A; const char* cB = cur.B;
    PG8_STAGE(PG8_SB(0, 0), cB, voffB); PG8_STAGE(PG8_SB(0, 1), cB + hstepB, voffB); PG8_STAGE(PG8_SA(0, 0), cA, voffA); PG8_STAGE(PG8_SA(0, 1), cA + hstepA, voffA);
    if (wr == 1) PG8_BAR;
    PG8_WAIT_V(2); PG8_BAR;
    PG8_STAGE(PG8_SB(1, 0), cB + kstep, voffB); PG8_STAGE(PG8_SA(1, 0), cA + kstep, voffA); PG8_STAGE(PG8_SB(1, 1), cB + hstepB + kstep, voffB);
    PG8_WAIT_V(6); PG8_BAR;
    for (;;) {
        const bool has_next = S.next(ui + 1, nxt);
        const char* nA = has_next ? nxt.A : cA; const char* nB = has_next ? nxt.B : cB;
        for (int t = 0; t < nt; t += 2) {
            const bool last = (t == nt - 2);
            const char* a1 = cA + (size_t)(t + 1) * kstep;
            const char* a2 = last ? nA : cA + (size_t)(t + 2) * kstep; const char* b2 = last ? nB : cB + (size_t)(t + 2) * kstep;
            const char* a3 = a2 + kstep; const char* b3 = b2 + kstep;
            PG8_LDB(B0, 0, 0); PG8_LDB(B1, 0, 1); PG8_SCHED; PG8_LDA(At, 0, 0); PG8_STAGE(PG8_SA(1, 1), a1 + hstepA, voffA);
            PG8_WAIT_V(8); PG8_WAIT_L(0); PG8_BAR; PG8_MMA(0, 0, At, B0); PG8_MMA(0, 1, At, B1); PG8_BAR; PG8_SCHED;
            PG8_LDA(At, 0, 1); PG8_STAGE(PG8_SB(0, 0), b2, voffB); PG8_STAGE(PG8_SB(0, 1), b2 + hstepB, voffB); PG8_STAGE(PG8_SA(0, 0), a2, voffA);
            PG8_WAIT_V(8); PG8_WAIT_L(0); PG8_BAR; PG8_MMA(1, 0, At, B0); PG8_MMA(1, 1, At, B1); PG8_BAR; PG8_SCHED;
            PG8_LDB(B0, 1, 0); PG8_LDB(B1, 1, 1); PG8_SCHED; PG8_LDA(At, 1, 0); PG8_STAGE(PG8_SA(0, 1), a2 + hstepA, voffA);
            PG8_WAIT_V(8); PG8_WAIT_L(0); PG8_BAR; PG8_MMA(0, 0, At, B0); PG8_MMA(0, 1, At, B1); PG8_BAR; PG8_SCHED;
            PG8_LDA(At, 1, 1); PG8_STAGE(PG8_SB(1, 0), b3, voffB); PG8_STAGE(PG8_SB(1, 1), b3 + hstepB, voffB); PG8_STAGE(PG8_SA(1, 0), a3, voffA);
            PG8_WAIT_V(8); PG8_WAIT_L(0); PG8_BAR; PG8_MMA(1, 0, At, B0); PG8_MMA(1, 1, At, B1); PG8_BAR; PG8_SCHED;
        }
        if constexpr (ALIGN_EPI) { if (wr == 0) PG8_BAR; }
        E(acc, cur, wr, wc, fr, fq);
        if (!has_next) break;
#pragma unroll
        for (int a = 0; a < 2; ++a)
#pragma unroll
            for (int b = 0; b < 2; ++b)
#pragma unroll
                for (int m = 0; m < 4; ++m)
#pragma unroll
                    for (int n = 0; n < 2; ++n) acc[a][b][m][n] = (f32x4){0.f, 0.f, 0.f, 0.f};
        cur = nxt; cA = nA; cB = nB; ++ui;
        if constexpr (ALIGN_EPI) { if (wr == 1) PG8_BAR; }
    }
    PG8_WAIT_V(0);
    if constexpr (!ALIGN_EPI) { if (wr == 0) PG8_BAR; }
    PG8_BAR;
#undef PG8_SA
#undef PG8_SB
#undef PG8_STAGE
#undef PG8_LDA
#undef PG8_LDB
#undef PG8_MMA
#undef PG8_WAIT_V
#undef PG8_WAIT_L
#undef PG8_BAR
#undef PG8_SCHED
}
}

using pg8::Unit;
struct SchedP1 {
    const char* XN; const char* W1T; int G, c;
    __device__ __forceinline__ bool next(int i, Unit& u) const {
        const int L = i * G + c; if (L >= 2048) return false;
        if (L < 1536) { pg8::tile_order(L, 64, 24, u.pm, u.pn); u.kind = (u.pn < 16) ? 0 : 1; u.A = XN + (size_t)u.pm * 256 * 1024 * 2; u.B = W1T + (size_t)u.pn * 256 * 1024 * 2; }
        else { pg8::tile_order(L - 1536, 8, 64, u.pm, u.pn); u.kind = 2; u.A = W1T + (size_t)(6144 + u.pm * 256) * 1024 * 2; u.B = XN + (size_t)u.pn * 256 * 1024 * 2; }
        return true;
    }
};
struct EpiP1 {
    static constexpr bool PERM = true;
    bf16_t* PROJ; bf16_t* GATES; bf16_t* VT; const float* bgate;
    __device__ __forceinline__ void operator()(const f32x4 (&acc)[2][2][4][2], const Unit& u, int wr, int wc, int fr, int fq) const {
        bf16_t* base; int ldc, colt; const float* bias = nullptr;
        if (u.kind == 0) { base = PROJ; ldc = PROJ_LD; colt = u.pn * 256; }
        else if (u.kind == 1) { base = GATES; ldc = 2048; colt = (u.pn - 16) * 256; bias = bgate + colt; }
        else { base = VT; ldc = MROWS; colt = u.pn * 256; }
        const int row0 = u.pm * 256 + wr * 64 + fr, col0 = colt + wc * 32 + 8 * fq;
        f32x4 bv[2][2];
#pragma unroll
        for (int bj = 0; bj < 2; ++bj)
#pragma unroll
            for (int n = 0; n < 2; ++n) bv[bj][n] = bias ? *(const f32x4*)(bias + wc * 32 + 8 * fq + bj * 128 + 4 * n) : (f32x4){0.f, 0.f, 0.f, 0.f};
#pragma unroll
        for (int ai = 0; ai < 2; ++ai)
#pragma unroll
            for (int m = 0; m < 4; ++m) { bf16_t* rowp = base + (size_t)(row0 + ai * 128 + m * 16) * ldc + col0;
#pragma unroll
                for (int bj = 0; bj < 2; ++bj) { f32x4 v0 = acc[ai][bj][m][0] + bv[bj][0], v1 = acc[ai][bj][m][1] + bv[bj][1];
                    if (u.kind == 1) {
#pragma unroll
                        for (int i = 0; i < 4; ++i) { v0[i] = fast_sigmoid(v0[i]); v1[i] = fast_sigmoid(v1[i]); } }
                    u32x4 w; w.x = cvtpk(v0[0], v0[1]); w.y = cvtpk(v0[2], v0[3]); w.z = cvtpk(v1[0], v1[1]); w.w = cvtpk(v1[2], v1[3]);
                    *(u32x4*)(rowp + bj * 128) = w; } }
    }
};
struct SchedP3 {
    const char* PROJ; const char* WBR; int G, c;
    __device__ __forceinline__ bool next(int i, Unit& u) const {
        const int L = i * G + c; if (L >= 512) return false;
        pg8::tile_order(L, 64, 8, u.pm, u.pn); u.kind = 0;
        u.A = PROJ + ((size_t)u.pm * 256 * PROJ_LD + (u.pn < 4 ? PC_SBQ : PC_DFQ)) * 2; u.B = WBR + (size_t)u.pn * 256 * 1024 * 2; return true;
    }
};
struct EpiP3 {
    static constexpr bool PERM = true;
    const bf16_t* GATES; bf16_t* Y;
    __device__ __forceinline__ void operator()(const f32x4 (&acc)[2][2][4][2], const Unit& u, int wr, int wc, int fr, int fq) const {
        const int row0 = u.pm * 256 + wr * 64 + fr, col0 = u.pn * 256 + wc * 32 + 8 * fq;
#pragma unroll
        for (int ai = 0; ai < 2; ++ai)
#pragma unroll
            for (int m = 0; m < 4; ++m) { const size_t off = (size_t)(row0 + ai * 128 + m * 16) * 2048 + col0;
#pragma unroll
                for (int bj = 0; bj < 2; ++bj) { const u32x4 g = *(const u32x4*)(GATES + off + bj * 128);
                    const f32x4 v0 = acc[ai][bj][m][0], v1 = acc[ai][bj][m][1]; u32x4 w;
                    w.x = cvtpk(v0[0] * bf2f(g.x & 0xffff), v0[1] * bf2f(g.x >> 16)); w.y = cvtpk(v0[2] * bf2f(g.y & 0xffff), v0[3] * bf2f(g.y >> 16));
                    w.z = cvtpk(v1[0] * bf2f(g.z & 0xffff), v1[1] * bf2f(g.z >> 16)); w.w = cvtpk(v1[2] * bf2f(g.w & 0xffff), v1[3] * bf2f(g.w >> 16));
                    *(u32x4*)(Y + off + bj * 128) = w; } }
    }
};
struct SchedN1024 {
    const char* A; const char* B; size_t lda_b, ldb_b; int G, c;
    __device__ __forceinline__ bool next(int i, Unit& u) const {
        const int L = i * G + c; if (L >= 256) return false;
        pg8::tile_order(L, 64, 4, u.pm, u.pn); u.kind = 0; u.A = A + (size_t)u.pm * 256 * lda_b; u.B = B + (size_t)u.pn * 256 * ldb_b; return true;
    }
};
struct EpiRes {
    static constexpr bool PERM = false;
    const float* base; float* out; bf16_t* outb; float* ss;
    __device__ __forceinline__ void operator()(const f32x4 (&acc)[2][2][4][2], const Unit& u, int wr, int wc, int fr, int fq) const {
        const int col0 = u.pn * 256 + wc * 32 + 4 * fq;
#pragma unroll
        for (int ai = 0; ai < 2; ++ai)
#pragma unroll
            for (int m = 0; m < 4; ++m) { const int row = u.pm * 256 + ai * 128 + wr * 64 + m * 16 + fr; const size_t off = (size_t)row * 1024 + col0; float q = 0.f;
#pragma unroll
                for (int bj = 0; bj < 2; ++bj)
#pragma unroll
                    for (int n = 0; n < 2; ++n) { const f32x4 o = *(const f32x4*)(base + off + bj * 128 + n * 16) + acc[ai][bj][m][n];
                        *(f32x4*)(out + off + bj * 128 + n * 16) = o; q += (o[0] * o[0] + o[1] * o[1]) + (o[2] * o[2] + o[3] * o[3]);
                        if (outb) { u32x2 w; w.x = cvtpk(o[0], o[1]); w.y = cvtpk(o[2], o[3]); *(u32x2*)(outb + off + bj * 128 + n * 16) = w; } }
                q += __shfl_xor(q, 16); q += __shfl_xor(q, 32);
                if (fq == 0) atomicAdd(ss + row, q); }
    }
};
struct SchedP5 {
    const char* A; const char* B; int G, c;
    __device__ __forceinline__ bool next(int i, Unit& u) const {
        const int L = i * G + c; if (L >= 64 * 22) return false;
        pg8::tile_order(L, 64, 22, u.pm, u.pn); u.kind = 0; u.A = A + (size_t)u.pm * 256 * 1024 * 2; u.B = B + (size_t)u.pn * 256 * 1024 * 2; return true;
    }
};
struct EpiP5 {
    static constexpr bool PERM = true;
    const float* ss; bf16_t* ACT;
    __device__ __forceinline__ void operator()(const f32x4 (&acc)[2][2][4][2], const Unit& u, int wr, int wc, int fr, int fq) const {
        const int col0 = u.pn * 128 + wc * 32 + 8 * fq;
#pragma unroll
        for (int ai = 0; ai < 2; ++ai)
#pragma unroll
            for (int m = 0; m < 4; ++m) { const int row = u.pm * 256 + ai * 128 + wr * 64 + m * 16 + fr; const float r = __builtin_amdgcn_rsqf(ss[row] * (1.0f / DM) + EPS);
                float o[8];
#pragma unroll
                for (int n = 0; n < 2; ++n)
#pragma unroll
                    for (int i = 0; i < 4; ++i) { const float g = acc[ai][0][m][n][i] * r, up = acc[ai][1][m][n][i] * r; o[4 * n + i] = g * fast_sigmoid(g) * up; }
                u32x4 w; w.x = cvtpk(o[0], o[1]); w.y = cvtpk(o[2], o[3]); w.z = cvtpk(o[4], o[5]); w.w = cvtpk(o[6], o[7]);
                *(u32x4*)(ACT + (size_t)row * DFF + col0) = w; }
    }
};

namespace att {
constexpr int KBYTES = 16384, VBYTES = 16384, TILE_BYTES = KBYTES + VBYTES;
constexpr int FLAG_OFF = 2 * TILE_BYTES;
constexpr int Q_OFF = FLAG_OFF + 64, QP = 272, QW = 32 * QP;
static_assert(Q_OFF % 16 == 0 && Q_OFF + 8 * QW <= 147456, "attention LDS map");
struct TileSrc { const bf16_t* k; const bf16_t* v; unsigned vp; };

__device__ __forceinline__ void tile_dma(const TileSrc& s, LAS unsigned char* buf, int wid, int lane) {
#pragma unroll
    for (int i = 0; i < 2; ++i) {
        const int piece = wid * 2 + i;
        { const int row = piece * 4 + (lane >> 4), cc = (lane & 15) ^ (row & 15); const unsigned off = (unsigned)(row * PROJ_LD + cc * 8);
          __builtin_amdgcn_global_load_lds((const unsigned*)(s.k + off), (LAS unsigned*)(buf + piece * 1024), 16, 0, 0); }
        { const int d = piece * 8 + (lane >> 3), cc = (lane & 7) ^ ((d >> 1) & 7); const unsigned off = (unsigned)d * s.vp + (unsigned)(cc * 8);
          __builtin_amdgcn_global_load_lds((const unsigned*)(s.v + off), (LAS unsigned*)(buf + KBYTES + piece * 1024), 16, 0, 0); }
    }
}
#define ATT_DMA_WAIT() asm volatile("s_waitcnt vmcnt(0)" ::: "memory")
__device__ __forceinline__ int pi32(int r) { return (r & 0x13) | ((r & 4) << 1) | ((r & 8) >> 1); }

struct Ctx {
    const bf16_t* PROJ; bf16_t* PROJW; const bf16_t* VT; const bf16_t* METAK; const bf16_t* METAV;
    const float* subln; float lam;
    LAS unsigned char* lds; int tid, lane, wid, r, h;
};
__device__ __forceinline__ TileSrc tile_src(const Ctx& c, int b, int j, int kcol, int vrow) {
    TileSrc s;
    if (j >= 0) { s.k = c.PROJ + ((size_t)(b * SEQ + 64 * j)) * PROJ_LD + kcol; s.v = c.VT + (size_t)vrow * MROWS + b * SEQ + 64 * j; s.vp = MROWS; }
    else { s.k = c.METAK + kcol; s.v = c.METAV + (size_t)vrow * 64; s.vp = 64; }
    return s;
}
__device__ __forceinline__ int k_addr(int sub, int r, int chunk) { const int row = 32 * sub + pi32(r); return row * 256 + ((chunk ^ (row & 15)) << 4); }
__device__ __forceinline__ int v_addr(int d, int chunk) { return KBYTES + d * 128 + ((chunk ^ ((d >> 1) & 7)) << 4); }

__device__ __forceinline__ void sb_unit(const Ctx& c, int b, int hd, int qb) {
    int lane = c.lane; asm volatile("" : "+v"(lane));
    const int tid = c.tid, r = lane & 31, h = lane >> 5, wid = c.wid;
    const int tq = 256 * qb + 32 * wid + r;
    const size_t qrow = (size_t)(b * SEQ + tq) * PROJ_LD + PC_SBQ + hd * 128;
    bf16x8 qf[8];
#pragma unroll
    for (int ks = 0; ks < 8; ++ks) qf[ks] = *(const bf16x8*)(c.PROJ + qrow + 16 * ks + 8 * h);
    f32x16 o[4];
#pragma unroll
    for (int dt = 0; dt < 4; ++dt) o[dt] = f32x16{};
    float C = 1.0f;
    const int jmax = 4 * qb + 3, NT = jmax + 2;
    const int kcolx = PC_SBK + hd * 128, vrow = hd * 128;
    LAS unsigned* flags = (LAS unsigned*)(c.lds + FLAG_OFF);
    if (tid == 0) { flags[0] = 0u; flags[1] = 0u; flags[2] = 0u; }
    {   const TileSrc s = tile_src(c, b, jmax, kcolx, vrow); tile_dma(s, c.lds, wid, lane); }
    ATT_DMA_WAIT(); __syncthreads();
    const int mydiag = 4 * qb + (wid >> 1);
    bool finished = false;
    for (int t = 0; t < NT; ++t) {
        const int j = (t <= jmax) ? jmax - t : -1;
        const LAS unsigned char* cur = c.lds + (t & 1) * TILE_BYTES;
        const bool more = (t + 1 < NT);
        if (more) { const int jn = (t + 1 <= jmax) ? jmax - (t + 1) : -1; const TileSrc s = tile_src(c, b, jn, kcolx, vrow); tile_dma(s, c.lds + ((t + 1) & 1) * TILE_BYTES, wid, lane); }
        const bool wave_active = (j < 0) || (j <= mydiag);
        if (wave_active && !finished) {
            const int lim = (j >= 0) ? (tq - 64 * j) : NMETA;
#pragma unroll
            for (int sub = 1; sub >= 0; --sub) {
                f32x16 s = f32x16{};
#pragma unroll
                for (int ks = 0; ks < 8; ++ks) { const bf16x8 a = *(const LAS bf16x8*)(cur + k_addr(sub, r, 2 * ks + h)); s = __builtin_amdgcn_mfma_f32_32x32x16_bf16(a, qf[ks], s, 0, 0, 0); }
                float av[16], fv[16];
#pragma unroll
                for (int reg = 0; reg < 16; ++reg) {
                    const int kap = 32 * sub + 16 * (reg >> 3) + 8 * h + (reg & 7);
                    const float z = __builtin_fminf(__builtin_fmaxf(s[reg], -115.f), 115.f);
                    const float e = __builtin_amdgcn_exp2f(-z); const float beta = __builtin_amdgcn_rcpf(1.0f + e); const float f = e * beta;
                    const bool valid = kap < lim; av[reg] = valid ? beta : 0.f; fv[reg] = valid ? f : 1.f;
                }
                float run = 1.f;
#pragma unroll
                for (int reg = 15; reg >= 8; --reg) { av[reg] *= run; run *= fv[reg]; }
                const float GU = run; run = 1.f;
#pragma unroll
                for (int reg = 7; reg >= 0; --reg) { av[reg] *= run; run *= fv[reg]; }
                const float GL = run;
                const float GUo = __shfl_xor(GU, 32), GLo = __shfl_xor(GL, 32);
                const float pU = GU * GUo, pL = GL * GLo;
                const float preU = h ? C : C * GUo, preL = h ? C * pU : (C * pU) * GLo;
                C = C * (pU * pL);
                u32x4 pf0, pf1;
                pf0.x = cvtpk(av[0] * preL, av[1] * preL); pf0.y = cvtpk(av[2] * preL, av[3] * preL); pf0.z = cvtpk(av[4] * preL, av[5] * preL); pf0.w = cvtpk(av[6] * preL, av[7] * preL);
                pf1.x = cvtpk(av[8] * preU, av[9] * preU); pf1.y = cvtpk(av[10] * preU, av[11] * preU); pf1.z = cvtpk(av[12] * preU, av[13] * preU); pf1.w = cvtpk(av[14] * preU, av[15] * preU);
                const bf16x8 p0 = __builtin_bit_cast(bf16x8, pf0), p1 = __builtin_bit_cast(bf16x8, pf1);
#pragma unroll
                for (int dt = 0; dt < 4; ++dt) {
                    const bf16x8 v0 = *(const LAS bf16x8*)(cur + v_addr(32 * dt + r, 4 * sub + h));
                    const bf16x8 v1 = *(const LAS bf16x8*)(cur + v_addr(32 * dt + r, 4 * sub + 2 + h));
                    o[dt] = __builtin_amdgcn_mfma_f32_32x32x16_bf16(v0, p0, o[dt], 0, 0, 0);
                    o[dt] = __builtin_amdgcn_mfma_f32_32x32x16_bf16(v1, p1, o[dt], 0, 0, 0);
                }
            }
            finished = __all(C < 1e-20f);
        }
#if SB_EARLY_EXIT
        const int fw = t % 3;
        if (!finished && lane == 0) flags[fw] = 1u;
        ATT_DMA_WAIT(); __syncthreads();
        const unsigned any_live = flags[fw];
        if (tid == 0) flags[(fw + 2) % 3] = 0u;
        if (!any_live) break;
#else
        ATT_DMA_WAIT(); __syncthreads();
#endif
    }
    bf16_t* orow = c.PROJW + qrow;
#pragma unroll
    for (int dt = 0; dt < 4; ++dt)
#pragma unroll
        for (int g = 0; g < 4; ++g) { u32x2 w; w.x = cvtpk(o[dt][4 * g], o[dt][4 * g + 1]); w.y = cvtpk(o[dt][4 * g + 2], o[dt][4 * g + 3]); *(u32x2*)(orow + 32 * dt + 8 * g + 4 * h) = w; }
}

__device__ __forceinline__ void df_unit(const Ctx& c, int b, int hd, int qb) {
    int lane = c.lane; asm volatile("" : "+v"(lane));
    const int r = lane & 31, h = lane >> 5, wid = c.wid;
    const int tq = 256 * qb + 32 * wid + r;
    const size_t qrow = (size_t)(b * SEQ + tq) * PROJ_LD + PC_DFQ + hd * 128;
    LAS unsigned char* qw = c.lds + Q_OFF + wid * QW;
    {   const size_t qbase = (size_t)(b * SEQ + 256 * qb + 32 * wid) * PROJ_LD + PC_DFQ + hd * 128;
#pragma unroll
        for (int i = 0; i < 8; ++i) { const int row = 4 * i + (lane >> 4), ch = lane & 15; const u32x4 v = *(const u32x4*)(c.PROJ + qbase + (size_t)row * PROJ_LD + ch * 8); *(LAS u32x4*)(qw + row * QP + ch * 16) = v; } }
    f32x16 o[2][4];
#pragma unroll
    for (int cm = 0; cm < 2; ++cm)
#pragma unroll
        for (int dt = 0; dt < 4; ++dt) o[cm][dt] = f32x16{};
    float mref[2] = {-INFINITY, -INFINITY}, lsum[2] = {0.f, 0.f};
    const float sl2 = __builtin_amdgcn_exp2f(-(float)(hd + 1)) * LOG2E;
    const int jmax = 4 * qb + 3, NT = jmax + 2;
    const int kcolx = PC_DFK + hd * 128, vrow = 1024 + hd * 128;
    {   const TileSrc s = tile_src(c, b, jmax, kcolx, vrow); tile_dma(s, c.lds, wid, lane); }
    ATT_DMA_WAIT(); __syncthreads();
    const int mychunk = 4 * qb + (wid >> 1);
    const LAS unsigned char* qfp = qw + r * QP + 16 * h;
    for (int t = 0; t < NT; ++t) {
        const int j = (t <= jmax) ? jmax - t : -1;
        const LAS unsigned char* cur = c.lds + (t & 1) * TILE_BYTES;
        const bool more = (t + 1 < NT);
        if (more) { const int jn = (t + 1 <= jmax) ? jmax - (t + 1) : -1; const TileSrc s = tile_src(c, b, jn, kcolx, vrow); tile_dma(s, c.lds + ((t + 1) & 1) * TILE_BYTES, wid, lane); }
        if (j < 0 || j <= mychunk) {
            const float tqf = (float)(j >= 0 ? tq - 64 * j : tq + NMETA);
            const bool meta = (j < 0);
#pragma unroll 1
            for (int sub = 1; sub >= 0; --sub) {
                u32x4 pf[2][2];
#pragma unroll
                for (int cm = 0; cm < 2; ++cm) {
                    f32x16 s = f32x16{};
#pragma unroll
                    for (int ks = 0; ks < 4; ++ks) { const bf16x8 a = *(const LAS bf16x8*)(cur + k_addr(sub, r, 8 * cm + 2 * ks + h)); const bf16x8 q = *(const LAS bf16x8*)(qfp + cm * 128 + ks * 32);
                        s = __builtin_amdgcn_mfma_f32_32x32x16_bf16(a, q, s, 0, 0, 0); }
                    float mx = -INFINITY;
#pragma unroll
                    for (int reg = 0; reg < 16; ++reg) {
                        const int kap = 32 * sub + 16 * (reg >> 3) + 8 * h + (reg & 7);
                        float v = __builtin_fmaf(-sl2, __builtin_fabsf(tqf - (float)kap), s[reg]);
                        if (meta && kap >= NMETA) v = -1e30f;
                        s[reg] = v; mx = __builtin_fmaxf(mx, v);
                    }
                    mx = __builtin_fmaxf(mx, __shfl_xor(mx, 32));
                    if (__any(mx > mref[cm] + 8.0f)) {
                        const float mnew = __builtin_fmaxf(mref[cm], mx), sc = __builtin_amdgcn_exp2f(mref[cm] - mnew);
                        lsum[cm] *= sc; mref[cm] = mnew;
#pragma unroll
                        for (int dt = 0; dt < 4; ++dt) o[cm][dt] *= sc;
                    }
                    float ps = 0.f;
#pragma unroll
                    for (int reg = 0; reg < 16; ++reg) { const float p = __builtin_amdgcn_exp2f(s[reg] - mref[cm]); s[reg] = p; ps += p; }
                    lsum[cm] += ps;
                    pf[cm][0].x = cvtpk(s[0], s[1]); pf[cm][0].y = cvtpk(s[2], s[3]); pf[cm][0].z = cvtpk(s[4], s[5]); pf[cm][0].w = cvtpk(s[6], s[7]);
                    pf[cm][1].x = cvtpk(s[8], s[9]); pf[cm][1].y = cvtpk(s[10], s[11]); pf[cm][1].z = cvtpk(s[12], s[13]); pf[cm][1].w = cvtpk(s[14], s[15]);
                    __builtin_amdgcn_sched_barrier(0);
                }
#pragma unroll
                for (int dt = 0; dt < 4; ++dt) {
                    const bf16x8 v0 = *(const LAS bf16x8*)(cur + v_addr(32 * dt + r, 4 * sub + h));
                    const bf16x8 v1 = *(const LAS bf16x8*)(cur + v_addr(32 * dt + r, 4 * sub + 2 + h));
#pragma unroll
                    for (int cm = 0; cm < 2; ++cm) {
                        o[cm][dt] = __builtin_amdgcn_mfma_f32_32x32x16_bf16(v0, __builtin_bit_cast(bf16x8, pf[cm][0]), o[cm][dt], 0, 0, 0);
                        o[cm][dt] = __builtin_amdgcn_mfma_f32_32x32x16_bf16(v1, __builtin_bit_cast(bf16x8, pf[cm][1]), o[cm][dt], 0, 0, 0);
                    }
                }
            }
        }
        ATT_DMA_WAIT(); __syncthreads();
    }
    const float L0 = lsum[0] + __shfl_xor(lsum[0], 32), L1 = lsum[1] + __shfl_xor(lsum[1], 32);
    const float i0 = 1.0f / L0, i1 = c.lam / L1;
    float ss = 0.f;
#pragma unroll
    for (int dt = 0; dt < 4; ++dt)
#pragma unroll
        for (int reg = 0; reg < 16; ++reg) { const float v = o[0][dt][reg] * i0 - o[1][dt][reg] * i1; o[0][dt][reg] = v; ss += v * v; }
    ss += __shfl_xor(ss, 32);
    __builtin_amdgcn_sched_barrier(0);
    const float rs = __builtin_amdgcn_rsqf(ss * (1.0f / 128.0f) + EPS) * 0.8f;
    bf16_t* orow = c.PROJW + qrow;
#pragma unroll
    for (int dt = 0; dt < 4; ++dt)
#pragma unroll
        for (int g = 0; g < 4; ++g) { const int d0 = 32 * dt + 8 * g + 4 * h; const f32x4 gn = *(const f32x4*)(c.subln + d0);
            u32x2 w; w.x = cvtpk(o[0][dt][4 * g] * rs * gn[0], o[0][dt][4 * g + 1] * rs * gn[1]); w.y = cvtpk(o[0][dt][4 * g + 2] * rs * gn[2], o[0][dt][4 * g + 3] * rs * gn[3]);
            *(u32x2*)(orow + d0) = w; }
}
}

__device__ __forceinline__ void transpose_item(const float* W, int ldw, int k0, int n0, bf16_t* WT, int ldwt, int drow0, int dcol0, int dup_off, float scale, const float* kscale, LAS float* scr, int lane) {
#pragma unroll 8
    for (int i = 0; i < 32; ++i) { const int kk = 2 * i + (lane >> 5); float v = W[(size_t)(k0 + kk) * ldw + n0 + (lane & 31)] * scale; if (kscale) v *= kscale[k0 + kk]; scr[kk * 33 + (lane & 31)] = v; }
    asm volatile("s_waitcnt lgkmcnt(0)" ::: "memory");
    const int cc = lane & 7;
#pragma unroll
    for (int jj = 0; jj < 4; ++jj) { const int n = (lane >> 3) + 8 * jj; const LAS float* s = scr + (8 * cc) * 33 + n;
        u32x4 ov; ov.x = cvtpk(s[0 * 33], s[1 * 33]); ov.y = cvtpk(s[2 * 33], s[3 * 33]); ov.z = cvtpk(s[4 * 33], s[5 * 33]); ov.w = cvtpk(s[6 * 33], s[7 * 33]);
        bf16_t* dst = WT + (size_t)(drow0 + n) * ldwt + dcol0 + k0 + 8 * cc;
        *(u32x4*)dst = ov; if (dup_off) *(u32x4*)(dst + dup_off) = ov; }
    asm volatile("s_waitcnt lgkmcnt(0)" ::: "memory");
}

struct Args { const float* in[19]; float* out; unsigned char* ws; int ph_lo, ph_hi; };

__global__ void __launch_bounds__(NTHREADS, 2) fwd_kernel(Args args) {
    extern __shared__ __attribute__((aligned(16))) unsigned char lds_raw[];
    LAS unsigned char* lds = (LAS unsigned char*)lds_raw;
    const int tid = threadIdx.x, lane = tid & 63, wid = __builtin_amdgcn_readfirstlane(tid >> 6);
    const int G = gridDim.x, bx = blockIdx.x;
    unsigned char* ws = args.ws;
    const float* x = args.in[0];
    bf16_t* W1T = (bf16_t*)(ws + WS_W1T); bf16_t* XN = (bf16_t*)(ws + WS_XN); bf16_t* PROJ = (bf16_t*)(ws + WS_PROJ); bf16_t* GATES = (bf16_t*)(ws + WS_GATES);
    bf16_t* METAK = (bf16_t*)(ws + WS_METAK); bf16_t* METAV = (bf16_t*)(ws + WS_METAV);
    bf16_t* WBR = (bf16_t*)(ws + WS_WBR); bf16_t* WOUT2 = (bf16_t*)(ws + WS_WOUT2); bf16_t* WFFN = (bf16_t*)(ws + WS_WFFN); bf16_t* WDOWN = (bf16_t*)(ws + WS_WDOWN);
    bf16_t* H1B = (bf16_t*)(ws + WS_H1B); bf16_t* ACT = (bf16_t*)(ws + WS_ACT); float* H1 = (float*)(ws + WS_H1);
    float* SS1 = (float*)(ws + CTL_SS1); float* SS2 = (float*)(ws + CTL_SS2);
    bf16_t* VT = (bf16_t*)args.out; bf16_t* Y = (bf16_t*)args.out;
    const int gw = bx * NWAVES + wid, NGW = G * NWAVES;
    const int lo = args.ph_lo, hi = args.ph_hi;
#define IN(k) (lo <= (k) && (k) < hi)
#if MK_N_LAUNCHES == 1
#define GRID_BAR() cg::this_grid().sync()
#else
#define GRID_BAR() do {} while (0)
#endif

    if (IN(0)) {
        LAS float* scr = (LAS float*)(lds + wid * 16384);
        const float* w_in = args.in[3]; const float* w_gate = args.in[4];
        const float cq_sb = LOG2E * 0.08838834764831845f, cq_df = LOG2E * 0.125f;
        for (int it = gw; it < 16 * 256; it += NGW) {
            const int kb = it >> 8, nb = it & 255, blk = nb >> 5, nin = (nb & 31) * 32;
            const float* src; int ldw, n0; float sc = 1.f;
            switch (blk) {
                case 0: src = w_in; ldw = 6144; n0 = 0 + nin; sc = cq_sb; break;
                case 1: src = w_in; ldw = 6144; n0 = 1024 + nin; break;
                case 2: src = w_in; ldw = 6144; n0 = 3072 + nin; sc = cq_df; break;
                case 3: src = w_in; ldw = 6144; n0 = 4096 + nin; break;
                case 4: src = w_gate; ldw = 2048; n0 = nin; break;
                case 5: src = w_gate; ldw = 2048; n0 = 1024 + nin; break;
                case 6: src = w_in; ldw = 6144; n0 = 2048 + nin; break;
                default: src = w_in; ldw = 6144; n0 = 5120 + nin; break;
            }
            transpose_item(src, ldw, kb * 64, n0, W1T, 1024, nb * 32, 0, 0, sc, nullptr, scr, lane);
        }
        {   const float* g = args.in[2];
            f32x4 gv[4];
#pragma unroll
            for (int jj = 0; jj < 4; ++jj) gv[jj] = *((const f32x4*)g + lane + 64 * jj);
            for (int m = gw; m < MROWS; m += NGW) {
                const f32x4* xr = (const f32x4*)(x + (size_t)m * DM) + lane; f32x4 v[4]; float s = 0.f;
#pragma unroll
                for (int jj = 0; jj < 4; ++jj) { v[jj] = xr[64 * jj]; s += (v[jj].x * v[jj].x + v[jj].y * v[jj].y) + (v[jj].z * v[jj].z + v[jj].w * v[jj].w); }
                const float rstd = __builtin_amdgcn_rsqf(wave_sum(s) * (1.0f / DM) + EPS);
                u32x2* o8 = (u32x2*)(XN + (size_t)m * DM) + lane;
#pragma unroll
                for (int jj = 0; jj < 4; ++jj) { u32x2 w; w.x = cvtpk(v[jj].x * rstd * gv[jj].x, v[jj].y * rstd * gv[jj].y); w.y = cvtpk(v[jj].z * rstd * gv[jj].z, v[jj].w * rstd * gv[jj].w); o8[64 * jj] = w; }
            }
        }
        if (bx < 32) {
            __syncthreads();
            LAS float* xm = (LAS float*)lds;
            LAS float* part = (LAS float*)(lds + 65536);
            const float* meta = args.in[1]; const float* g = args.in[2];
            for (int rr = 0; rr < 2; ++rr) { const int row = 2 * wid + rr; const f32x4* xr = (const f32x4*)(meta + (size_t)row * DM) + lane; f32x4 v[4]; float s = 0.f;
#pragma unroll
                for (int jj = 0; jj < 4; ++jj) { v[jj] = xr[64 * jj]; s += (v[jj].x * v[jj].x + v[jj].y * v[jj].y) + (v[jj].z * v[jj].z + v[jj].w * v[jj].w); }
                const float rstd = __builtin_amdgcn_rsqf(wave_sum(s) * (1.0f / DM) + EPS);
#pragma unroll
                for (int jj = 0; jj < 4; ++jj) { const f32x4 gg = *((const f32x4*)g + lane + 64 * jj); f32x4 w = v[jj] * rstd * gg; *(LAS f32x4*)(xm + row * 1024 + 4 * (lane + 64 * jj)) = w; } }
            __syncthreads();
            const int cl = tid & 127, kq = tid >> 7, blk = bx >> 3, col = (bx & 7) * 128 + cl;
            const int srcc = (blk == 0 ? 1024 : blk == 1 ? 2048 : blk == 2 ? 4096 : 5120) + col;
            float acc[16];
#pragma unroll
            for (int i = 0; i < 16; ++i) acc[i] = 0.f;
            for (int k = kq * 256; k < kq * 256 + 256; ++k) { const float w = w_in[(size_t)k * 6144 + srcc];
#pragma unroll
                for (int i = 0; i < 16; ++i) acc[i] = __builtin_fmaf(xm[i * 1024 + k], w, acc[i]); }
#pragma unroll
            for (int i = 0; i < 16; ++i) part[(kq * 16 + i) * 128 + cl] = acc[i];
            __syncthreads();
            if (blk == 0 || blk == 2) {
                const int row = tid >> 5, c4 = (tid & 31) * 4; float v[4];
#pragma unroll
                for (int i = 0; i < 4; ++i) v[i] = (part[(0 * 16 + row) * 128 + c4 + i] + part[(1 * 16 + row) * 128 + c4 + i]) + (part[(2 * 16 + row) * 128 + c4 + i] + part[(3 * 16 + row) * 128 + c4 + i]);
                const int dcol = (blk == 2 ? PC_DFK : PC_SBK) + (bx & 7) * 128 + c4;
                u32x2 w; w.x = cvtpk(v[0], v[1]); w.y = cvtpk(v[2], v[3]); *(u32x2*)(METAK + (size_t)row * PROJ_LD + dcol) = w;
                const u32x2 z = {0u, 0u};
#pragma unroll
                for (int i = 0; i < 3; ++i) *(u32x2*)(METAK + (size_t)(16 + row + 16 * i) * PROJ_LD + dcol) = z;
            } else if (tid < 128) {
                float v[16];
#pragma unroll
                for (int i = 0; i < 16; ++i) v[i] = (part[(0 * 16 + i) * 128 + cl] + part[(1 * 16 + i) * 128 + cl]) + (part[(2 * 16 + i) * 128 + cl] + part[(3 * 16 + i) * 128 + cl]);
                bf16_t* dst = METAV + (size_t)((blk == 3 ? 1024 : 0) + col) * 64;
                u32x4 w0, w1; const u32x4 z = {0u, 0u, 0u, 0u};
                w0.x = cvtpk(v[0], v[1]); w0.y = cvtpk(v[2], v[3]); w0.z = cvtpk(v[4], v[5]); w0.w = cvtpk(v[6], v[7]);
                w1.x = cvtpk(v[8], v[9]); w1.y = cvtpk(v[10], v[11]); w1.z = cvtpk(v[12], v[13]); w1.w = cvtpk(v[14], v[15]);
                *(u32x4*)(dst) = w0; *(u32x4*)(dst + 8) = w1;
#pragma unroll
                for (int i = 2; i < 8; ++i) *(u32x4*)(dst + 8 * i) = z;
            }
        }
        if (IN(1)) GRID_BAR();
    }

    if (IN(1)) {
        SchedP1 S{(const char*)XN, (const char*)W1T, G, bx};
        EpiP1 E{PROJ, GATES, VT, args.in[5]};
        pg8::gemm_phase<EpiP1, SchedP1, true>(lds, 1024, 1024, 1024, S, E);
        if (IN(2)) GRID_BAR();
    }

    if (IN(2)) {
        {   LAS float* scr = (LAS float*)(lds + wid * 16384);
            const float* w_br_sb = args.in[11]; const float* w_br_df = args.in[12]; const float* w_out = args.in[13]; const float* gffn = args.in[14];
            const float* w_fg = args.in[15]; const float* w_fu = args.in[16]; const float* w_fd = args.in[17];
            constexpr int I_BR = 16 * 32, I_FFN = 16 * 176, I_DN = 44 * 32, I_ALL = 3 * I_BR + I_FFN + I_DN;
            for (int it0 = gw; it0 < I_ALL; it0 += NGW) {
                int it = it0;
                if (it < I_BR) { transpose_item(w_br_sb, 1024, (it >> 5) * 64, (it & 31) * 32, WBR, 1024, (it & 31) * 32, 0, 0, 1.f, nullptr, scr, lane); continue; } it -= I_BR;
                if (it < I_BR) { transpose_item(w_br_df, 1024, (it >> 5) * 64, (it & 31) * 32, WBR, 1024, 1024 + (it & 31) * 32, 0, 0, 1.f, nullptr, scr, lane); continue; } it -= I_BR;
                if (it < I_BR) { transpose_item(w_out, 1024, (it >> 5) * 64, (it & 31) * 32, WOUT2, 2048, (it & 31) * 32, 0, 1024, 1.f, nullptr, scr, lane); continue; } it -= I_BR;
                if (it < I_FFN) { const int kb = it / 176, nb = it % 176, R = nb * 32, p = R >> 8, rr = R & 255;
                    const float* src = (rr < 128) ? w_fg : w_fu; const int n0 = 128 * p + (rr & 127);
                    transpose_item(src, DFF, kb * 64, n0, WFFN, 1024, R, 0, 0, 1.f, gffn, scr, lane); continue; } it -= I_FFN;
                transpose_item(w_fd, 1024, (it >> 5) * 64, (it & 31) * 32, WDOWN, DFF, (it & 31) * 32, 0, 0, 1.f, nullptr, scr, lane);
            }
        }
        __syncthreads();
        att::Ctx c; c.PROJ = PROJ; c.PROJW = PROJ; c.VT = VT; c.METAK = METAK; c.METAV = METAV; c.subln = args.in[10]; c.lds = lds; c.tid = tid; c.lane = lane; c.wid = wid; c.r = lane & 31; c.h = lane >> 5;
        {   const float a1 = args.in[6][lane] * args.in[7][lane], a2 = args.in[8][lane] * args.in[9][lane];
            c.lam = __expf(wave_sum(a1)) - __expf(wave_sum(a2)) + 0.2f; }
        LAS unsigned* flags = (LAS unsigned*)(lds + att::FLAG_OFF);
        if (tid < 8) flags[tid] = 0u;
        __syncthreads();
        unsigned* queue = (unsigned*)(ws + CTL_QUEUE);
        for (;;) {
            if (tid == 0) flags[4] = atomicAdd(queue, 1u);
            __syncthreads();
            const unsigned u = flags[4];
            __syncthreads();
            if (u >= 1024u) break;
            if (u < 512u) {
#ifndef NO_DF
                const int qb = 31 - (int)(u >> 4), hb = (int)(u & 15), hd = 7 - (hb >> 1), b = hb & 1; att::df_unit(c, b, hd, qb);
#endif
            }
            else {
#ifndef NO_SB
                const unsigned v = u - 512u; const int qb = 31 - (int)(v >> 4), hb = (int)(v & 15), hd = hb >> 1, b = hb & 1; att::sb_unit(c, b, hd, qb);
#endif
            }
        }
        if (IN(3)) GRID_BAR();
    }

    if (IN(3)) {
        SchedP3 S{(const char*)PROJ, (const char*)WBR, G, bx};
        EpiP3 E{GATES, Y};
        pg8::gemm_phase<EpiP3, SchedP3, true>(lds, 1024, PROJ_LD, 1024, S, E);
        if (IN(4)) GRID_BAR();
    }

    if (IN(4)) {
        SchedN1024 S{(const char*)Y, (const char*)WOUT2, (size_t)2048 * 2, (size_t)2048 * 2, G, bx};
        EpiRes E{x, H1, H1B, SS1};
        pg8::gemm_phase<EpiRes, SchedN1024, false>(lds, 2048, 2048, 2048, S, E);
        if (IN(5)) GRID_BAR();
    }

    if (IN(5)) {
        SchedP5 S{(const char*)H1B, (const char*)WFFN, G, bx};
        EpiP5 E{SS1, ACT};
        pg8::gemm_phase<EpiP5, SchedP5, true>(lds, 1024, 1024, 1024, S, E);
        if (IN(6)) GRID_BAR();
    }

    if (IN(6)) {
        SchedN1024 S{(const char*)ACT, (const char*)WDOWN, (size_t)DFF * 2, (size_t)DFF * 2, G, bx};
        EpiRes E{H1, args.out, nullptr, SS2};
        pg8::gemm_phase<EpiRes, SchedN1024, false>(lds, DFF, DFF, DFF, S, E);
        if (IN(7)) GRID_BAR();
    }

    if (IN(7)) {
        const float* g = args.in[18];
        f32x4 gv[4];
#pragma unroll
        for (int jj = 0; jj < 4; ++jj) gv[jj] = *((const f32x4*)g + lane + 64 * jj);
        for (int m = gw; m < MROWS; m += NGW) {
            f32x4* xr = (f32x4*)(args.out + (size_t)m * DM) + lane; const float rstd = __builtin_amdgcn_rsqf(SS2[m] * (1.0f / DM) + EPS);
#pragma unroll
            for (int jj = 0; jj < 4; ++jj) { f32x4 v = xr[64 * jj]; v = v * rstd * gv[jj]; xr[64 * jj] = v; }
        }
    }
#undef IN
}

constexpr int LDS_BYTES = 147456;
extern "C" void kernel_launch(void* const* d_in, const int* in_sizes, int n_in, void* d_out, int out_size, void* d_ws, size_t ws_size, hipStream_t stream) {
    static int grid = 0;
    if (grid == 0) {
        if (n_in != 19 || out_size != MROWS * DM || ws_size < WS_END) { fprintf(stderr, "kernel_launch: unexpected shapes (n_in %d out %d ws %zu)\n", n_in, out_size, ws_size); grid = -1; return; }
        int dev = 0, cus = 0, per_cu = 0;
        hipGetDevice(&dev); hipDeviceGetAttribute(&cus, hipDeviceAttributeMultiprocessorCount, dev);
        if (hipFuncSetAttribute((const void*)fwd_kernel, hipFuncAttributeMaxDynamicSharedMemorySize, LDS_BYTES) != hipSuccess) { fprintf(stderr, "kernel_launch: hipFuncSetAttribute failed\n"); grid = -1; return; }
        if (hipOccupancyMaxActiveBlocksPerMultiprocessor(&per_cu, (const void*)fwd_kernel, NTHREADS, LDS_BYTES) != hipSuccess || per_cu < 1) { fprintf(stderr, "kernel_launch: occupancy query says %d\n", per_cu); per_cu = 1; }
        (void)hipGetLastError();
        grid = cus * 1;
    }
    if (grid < 0) return;
    (void)hipMemsetAsync((char*)d_ws + WS_CTL, 0, CTL_BYTES, stream);
    Args a{};
    for (int i = 0; i < 19; ++i) a.in[i] = (const float*)d_in[i];
    a.out = (float*)d_out; a.ws = (unsigned char*)d_ws;
#if MK_N_LAUNCHES == 1
    a.ph_lo = 0; a.ph_hi = 8;
    void* kargs[] = {&a};
    hipError_t e = hipLaunchCooperativeKernel((const void*)fwd_kernel, dim3(grid), dim3(NTHREADS), kargs, LDS_BYTES, stream);
    if (e != hipSuccess) fprintf(stderr, "kernel_launch: cooperative launch failed: %s (grid %d)\n", hipGetErrorString(e), grid);
#else
    for (int p = 0; p < 8; ++p) { a.ph_lo = p; a.ph_hi = p + 1; hipLaunchKernelGGL(fwd_kernel, dim3(grid), dim3(NTHREADS), LDS_BYTES, stream, a); }
#endif
}
```

```cpp
#include <hip/hip_runtime.h>
#include <hip/hip_cooperative_groups.h>
#include <cstdio>
#include <cstdint>
namespace cg = cooperative_groups;

#ifndef MK_N_LAUNCHES
#define MK_N_LAUNCHES 1
#endif
#ifndef SB_EARLY_EXIT
#define SB_EARLY_EXIT 1
#endif

#define LAS __attribute__((address_space(3)))
typedef unsigned short bf16_t;
typedef short bf16x8 __attribute__((ext_vector_type(8)));
typedef float f32x4 __attribute__((ext_vector_type(4)));
typedef float f32x16 __attribute__((ext_vector_type(16)));
typedef unsigned u32x4 __attribute__((ext_vector_type(4)));
typedef unsigned u32x2 __attribute__((ext_vector_type(2)));
typedef float f32x2_t __attribute__((ext_vector_type(2)));
typedef __bf16 bf16x2_t __attribute__((ext_vector_type(2)));

constexpr int SEQ = 8192, DM = 1024, MROWS = 2 * SEQ, NMETA = 16, DFF = 2816;
constexpr float EPS = 1e-6f;
constexpr float LOG2E = 1.4426950408889634f;
constexpr int NWAVES = 8, NTHREADS = 512;
constexpr int PROJ_LD = 4096;
constexpr int PC_SBQ = 0, PC_SBK = 1024, PC_DFQ = 2048, PC_DFK = 3072;

constexpr size_t MiB = 1u << 20;
constexpr size_t WS_CTL = 0, CTL_BYTES = 1 * MiB;
constexpr size_t CTL_QUEUE = 256;
constexpr size_t CTL_BAR = 64 * 1024;
constexpr size_t CTL_SS1 = 256 * 1024, CTL_SS2 = 512 * 1024;
constexpr size_t WS_W1T = 1 * MiB;
constexpr size_t WS_METAK = 17 * MiB;
constexpr size_t WS_METAV = WS_METAK + 512 * 1024;
constexpr size_t WS_XN = 18 * MiB;
constexpr size_t WS_WBR = 18 * MiB;
constexpr size_t WS_WOUT2 = 22 * MiB;
constexpr size_t WS_WFFN = 26 * MiB;
constexpr size_t WS_WDOWN = 38 * MiB;
constexpr size_t WS_PROJ = 50 * MiB;
constexpr size_t WS_H1B = 50 * MiB;
constexpr size_t WS_ACT = 82 * MiB;
constexpr size_t WS_GATES = 178 * MiB;
constexpr size_t WS_H1 = 178 * MiB;
constexpr size_t WS_END = 242 * MiB;

__device__ __forceinline__ unsigned cvtpk(float lo, float hi) { f32x2_t v = {lo, hi}; bf16x2_t b = __builtin_convertvector(v, bf16x2_t); return __builtin_bit_cast(unsigned, b); }
__device__ __forceinline__ float bf2f(unsigned short b) { return __builtin_bit_cast(float, (unsigned)b << 16); }
__device__ __forceinline__ float wave_sum(float v) {
#pragma unroll
    for (int o = 1; o < 64; o <<= 1) v += __shfl_xor(v, o);
    return v;
}
__device__ __forceinline__ float fast_sigmoid(float x) { return __builtin_amdgcn_rcpf(1.0f + __builtin_amdgcn_exp2f(-x * LOG2E)); }

namespace pg8 {
constexpr int BM = 256, BK = 64, HALF = 128, HTB = HALF * BK * 2, STAGE_BYTES = 8 * HTB, NXCD = 8, WGM = 8;
__host__ __device__ __forceinline__ int lds_byte(int r, int c) { const int st = (r >> 4) * 2 + (c >> 5), rr = r & 15, cc = c & 31, ob = rr * 64 + cc * 2; return st * 1024 + (ob ^ (((ob >> 9) & 1) << 5)); }
__host__ __device__ __forceinline__ void stage_rc(int b, int& R, int& C) { const int st = b / 1024, sb = b % 1024, swz = sb ^ (((sb >> 9) & 1) << 5); R = (st >> 1) * 16 + swz / 64; C = (st & 1) * 32 + (swz % 64) / 2; }
__host__ __device__ __forceinline__ int perm32(int rho) { const int n = rho >> 4, i = rho & 15; return 8 * (i >> 2) + 4 * n + (i & 3); }

struct Unit { int pm, pn, kind; const char* A; const char* B; };
__device__ __forceinline__ void tile_order(int wgid, int nM, int nN, int& pm, int& pn) {
    const int nwg = nM * nN;
    { const int q = nwg / NXCD, r = nwg % NXCD, xcd = wgid % NXCD, off = wgid / NXCD; wgid = (xcd < r ? xcd * (q + 1) : r * (q + 1) + (xcd - r) * q) + off; }
    const int nig = WGM * nN, gid = wgid / nig, fm = gid * WGM, gsz = (nM - fm) < WGM ? (nM - fm) : WGM;
    pm = fm + ((wgid % nig) % gsz); pn = (wgid % nig) / gsz;
}
template <class Epi, class Sched, bool ALIGN_EPI>
__device__ __forceinline__ void gemm_phase(LAS unsigned char* lds, const int K, const int lda, const int ldb, const Sched& S, const Epi& E) {
    const int tid = threadIdx.x, wid = __builtin_amdgcn_readfirstlane(tid >> 6), lane = tid & 63, wr = wid >> 2, wc = wid & 3, fr = lane & 15, fq = lane >> 4;
    const int nt = K / BK;
    unsigned voffA[2], voffB[2];
#pragma unroll
    for (int i = 0; i < 2; ++i) { int R, C; stage_rc(tid * 16 + i * 8192, R, C); const int Rb = Epi::PERM ? ((R & ~31) + perm32(R & 31)) : R;
        voffA[i] = (unsigned)(R * lda + C) * 2u; voffB[i] = (unsigned)(Rb * ldb + C) * 2u; }
    const size_t kstep = (size_t)(BK * 2);
    const size_t hstepA = (size_t)HALF * lda * 2, hstepB = (size_t)HALF * ldb * 2;
    const unsigned ldsw = (unsigned)wid * 1024u;
    const int aoff = lds_byte(wr * 64 + fr, fq * 8), boff = lds_byte(wc * 32 + fr, fq * 8);
#define PG8_SA(b, h) (((b) * 2 + (h)) * HTB)
#define PG8_SB(b, h) ((4 + (b) * 2 + (h)) * HTB)
#define PG8_STAGE(bufoff, gbase, voff) do { _Pragma("unroll") for (int _i = 0; _i < 2; ++_i) \
        __builtin_amdgcn_global_load_lds((const unsigned*)((const char*)(gbase) + (voff)[_i]), (LAS unsigned*)(lds + (bufoff) + ldsw + _i * 8192), 16, 0, 0); } while (0)
#define PG8_LDA(dst, b, h) do { _Pragma("unroll") for (int m = 0; m < 4; ++m) _Pragma("unroll") for (int k = 0; k < 2; ++k) dst[m][k] = *(const LAS bf16x8*)(lds + PG8_SA(b, h) + aoff + m * 2048 + k * 1024); } while (0)
#define PG8_LDB(dst, b, h) do { _Pragma("unroll") for (int n = 0; n < 2; ++n) _Pragma("unroll") for (int k = 0; k < 2; ++k) dst[n][k] = *(const LAS bf16x8*)(lds + PG8_SB(b, h) + boff + n * 2048 + k * 1024); } while (0)
#define PG8_MMA(ai, bj, At, Bt) do { __builtin_amdgcn_s_setprio(1); _Pragma("unroll") for (int m = 0; m < 4; ++m) _Pragma("unroll") for (int n = 0; n < 2; ++n) _Pragma("unroll") for (int k = 0; k < 2; ++k) \
        acc[ai][bj][m][n] = __builtin_amdgcn_mfma_f32_16x16x32_bf16(Bt[n][k], At[m][k], acc[ai][bj][m][n], 0, 0, 0); __builtin_amdgcn_s_setprio(0); } while (0)
#define PG8_WAIT_V(n) asm volatile("s_waitcnt vmcnt(" #n ")" ::: "memory")
#define PG8_WAIT_L(n) asm volatile("s_waitcnt lgkmcnt(" #n ")" ::: "memory")
#define PG8_BAR __builtin_amdgcn_s_barrier()
#define PG8_SCHED __builtin_amdgcn_sched_barrier(0)
    Unit cur, nxt; int ui = 0;
    if (!S.next(0, cur)) return;
    f32x4 acc[2][2][4][2];
#pragma unroll
    for (int a = 0; a < 2; ++a)
#pragma unroll
        for (int b = 0; b < 2; ++b)
#pragma unroll
            for (int m = 0; m < 4; ++m)
#pragma unroll
                for (int n = 0; n < 2; ++n) acc[a][b][m][n] = (f32x4){0.f, 0.f, 0.f, 0.f};
    bf16x8 At[4][2], B0[2][2], B1[2][2];
    const char* cA = cur.A; const char* cB = cur.B;
    PG8_STAGE(PG8_SB(0, 0), cB, voffB); PG8_STAGE(PG8_SB(0, 1), cB + hstepB, voffB); PG8_STAGE(PG8_SA(0, 0), cA, voffA); PG8_STAGE(PG8_SA(0, 1), cA + hstepA, voffA);
    if (wr == 1) PG8_BAR;
    PG8_WAIT_V(2); PG8_BAR;
    PG8_STAGE(PG8_SB(1, 0), cB + kstep, voffB); PG8_STAGE(PG8_SA(1, 0), cA + kstep, voffA); PG8_STAGE(PG8_SB(1, 1), cB + hstepB + kstep, voffB);
    PG8_WAIT_V(6); PG8_BAR;
    for (;;) {
        const bool has_next = S.next(ui + 1, nxt);
        const char* nA = has_next ? nxt.A : cA; const char* nB = has_next ? nxt.B : cB;
        for (int t = 0; t < nt; t += 2) {
            const bool last = (t == nt - 2);
            const char* a1 = cA + (size_t)(t + 1) * kstep;
            const char* a2 = last ? nA : cA + (size_t)(t + 2) * kstep; const char* b2 = last ? nB : cB + (size_t)(t + 2) * kstep;
            const char* a3 = a2 + kstep; const char* b3 = b2 + kstep;
            PG8_LDB(B0, 0, 0); PG8_LDB(B1, 0, 1); PG8_SCHED; PG8_LDA(At, 0, 0); PG8_STAGE(PG8_SA(1, 1), a1 + hstepA, voffA);
            PG8_WAIT_V(8); PG8_WAIT_L(0); PG8_BAR; PG8_MMA(0, 0, At, B0); PG8_MMA(0, 1, At, B1); PG8_BAR; PG8_SCHED;
            PG8_LDA(At, 0, 1); PG8_STAGE(PG8_SB(0, 0), b2, voffB); PG8_STAGE(PG8_SB(0, 1), b2 + hstepB, voffB); PG8_STAGE(PG8_SA(0, 0), a2, voffA);
            PG8_WAIT_V(8); PG8_WAIT_L(0); PG8_BAR; PG8_MMA(1, 0, At, B0); PG8_MMA(1, 1, At, B1); PG8_BAR; PG8_SCHED;
            PG8_LDB(B0, 1, 0); PG8_LDB(B1, 1, 1); PG8_SCHED; PG8_LDA(At, 1, 0); PG8_STAGE(PG8_SA(0, 1), a2 + hstepA, voffA);
            PG8_WAIT_V(8); PG8_WAIT_L(0); PG8_BAR; PG8_MMA(0, 0, At, B0); PG8_MMA(0, 1, At, B1); PG8_BAR; PG8_SCHED;
            PG8_LDA(At, 1, 1); PG8_STAGE(PG8_SB(1, 0), b3, voffB); PG8_STAGE(PG8_SB(1, 1), b3 + hstepB, voffB); PG8_STAGE(PG8_SA(1, 0), a3, voffA);
            PG8_WAIT_V(8); PG8_WAIT_L(0); PG8_BAR; PG8_MMA(1, 0, At, B0); PG8_MMA(1, 1, At, B1); PG8_BAR; PG8_SCHED;
        }
        if constexpr (ALIGN_EPI) { if (wr == 0) PG8_BAR; }
        E(acc, cur, wr, wc, fr, fq);
        if (!has_next) break;
#pragma unroll
        for (int a = 0; a < 2; ++a)
#pragma unroll
            for (int b = 0; b < 2; ++b)
#pragma unroll
                for (int m = 0; m < 4; ++m)
#pragma unroll
                    for (int n = 0; n < 2; ++n) acc[a][b][m][n] = (f32x4){0.f, 0.f, 0.f, 0.f};
        cur = nxt; cA = nA; cB = nB; ++ui;
        if constexpr (ALIGN_EPI) { if (wr == 1) PG8_BAR; }
    }
    PG8_WAIT_V(0);
    if constexpr (!ALIGN_EPI) { if (wr == 0) PG8_BAR; }
    PG8_BAR;
#undef PG8_SA
#undef PG8_SB
#undef PG8_STAGE
#undef PG8_LDA
#undef PG8_LDB
#undef PG8_MMA
#undef PG8_WAIT_V
#undef PG8_WAIT_L
#undef PG8_BAR
#undef PG8_SCHED
}
}

using pg8::Unit;
struct SchedP1 {
    const char* XN; const char* W1T; int G, c;
    __device__ __forceinline__ bool next(int i, Unit& u) const {
        const int L = i * G + c; if (L >= 2048) return false;
        if (L < 1536) { pg8::tile_order(L, 64, 24, u.pm, u.pn); u.kind = (u.pn < 16) ? 0 : 1; u.A = XN + (size_t)u.pm * 256 * 1024 * 2; u.B = W1T + (size_t)u.pn * 256 * 1024 * 2; }
        else { pg8::tile_order(L - 1536, 8, 64, u.pm, u.pn); u.kind = 2; u.A = W1T + (size_t)(6144 + u.pm * 256) * 1024 * 2; u.B = XN + (size_t)u.pn * 256 * 1024 * 2; }
        return true;
    }
};
struct EpiP1 {
    static constexpr bool PERM = true;
    bf16_t* PROJ; bf16_t* GATES; bf16_t* VT; const float* bgate;
    __device__ __forceinline__ void operator()(const f32x4 (&acc)[2][2][4][2], const Unit& u, int wr, int wc, int fr, int fq) const {
        bf16_t* base; int ldc, colt; const float* bias = nullptr;
        if (u.kind == 0) { base = PROJ; ldc = PROJ_LD; colt = u.pn * 256; }
        else if (u.kind == 1) { base = GATES; ldc = 2048; colt = (u.pn - 16) * 256; bias = bgate + colt; }
        else { base = VT; ldc = MROWS; colt = u.pn * 256; }
        const int row0 = u.pm * 256 + wr * 64 + fr, col0 = colt + wc * 32 + 8 * fq;
        f32x4 bv[2][2];
#pragma unroll
        for (int bj = 0; bj < 2; ++bj)
#pragma unroll
            for (int n = 0; n < 2; ++n) bv[bj][n] = bias ? *(const f32x4*)(bias + wc * 32 + 8 * fq + bj * 128 + 4 * n) : (f32x4){0.f, 0.f, 0.f, 0.f};
#pragma unroll
        for (int ai = 0; ai < 2; ++ai)
#pragma unroll
            for (int m = 0; m < 4; ++m) { bf16_t* rowp = base + (size_t)(row0 + ai * 128 + m * 16) * ldc + col0;
#pragma unroll
                for (int bj = 0; bj < 2; ++bj) { f32x4 v0 = acc[ai][bj][m][0] + bv[bj][0], v1 = acc[ai][bj][m][1] + bv[bj][1];
                    if (u.kind == 1) {
#pragma unroll
                        for (int i = 0; i < 4; ++i) { v0[i] = fast_sigmoid(v0[i]); v1[i] = fast_sigmoid(v1[i]); } }
                    u32x4 w; w.x = cvtpk(v0[0], v0[1]); w.y = cvtpk(v0[2], v0[3]); w.z = cvtpk(v1[0], v1[1]); w.w = cvtpk(v1[2], v1[3]);
                    *(u32x4*)(rowp + bj * 128) = w; } }
    }
};
struct SchedP3 {
    const char* PROJ; const char* WBR; int G, c;
    __device__ __forceinline__ bool next(int i, Unit& u) const {
        const int L = i * G + c; if (L >= 512) return false;
        pg8::tile_order(L, 64, 8, u.pm, u.pn); u.kind = 0;
        u.A = PROJ + ((size_t)u.pm * 256 * PROJ_LD + (u.pn < 4 ? PC_SBQ : PC_DFQ)) * 2; u.B = WBR + (size_t)u.pn * 256 * 1024 * 2; return true;
    }
};
struct EpiP3 {
    static constexpr bool PERM = true;
    const bf16_t* GATES; bf16_t* Y;
    __device__ __forceinline__ void operator()(const f32x4 (&acc)[2][2][4][2], const Unit& u, int wr, int wc, int fr, int fq) const {
        const int row0 = u.pm * 256 + wr * 64 + fr, col0 = u.pn * 256 + wc * 32 + 8 * fq;
#pragma unroll
        for (int ai = 0; ai < 2; ++ai)
#pragma unroll
            for (int m = 0; m < 4; ++m) { const size_t off = (size_t)(row0 + ai * 128 + m * 16) * 2048 + col0;
#pragma unroll
                for (int bj = 0; bj < 2; ++bj) { const u32x4 g = *(const u32x4*)(GATES + off + bj * 128);
                    const f32x4 v0 = acc[ai][bj][m][0], v1 = acc[ai][bj][m][1]; u32x4 w;
                    w.x = cvtpk(v0[0] * bf2f(g.x & 0xffff), v0[1] * bf2f(g.x >> 16)); w.y = cvtpk(v0[2] * bf2f(g.y & 0xffff), v0[3] * bf2f(g.y >> 16));
                    w.z = cvtpk(v1[0] * bf2f(g.z & 0xffff), v1[1] * bf2f(g.z >> 16)); w.w = cvtpk(v1[2] * bf2f(g.w & 0xffff), v1[3] * bf2f(g.w >> 16));
                    *(u32x4*)(Y + off + bj * 128) = w; } }
    }
};
struct SchedN1024 {
    const char* A; const char* B; size_t lda_b, ldb_b; int G, c;
    __device__ __forceinline__ bool next(int i, Unit& u) const {
        const int L = i * G + c; if (L >= 256) return false;
        pg8::tile_order(L, 64, 4, u.pm, u.pn); u.kind = 0; u.A = A + (size_t)u.pm * 256 * lda_b; u.B = B + (size_t)u.pn * 256 * ldb_b; return true;
    }
};
struct EpiRes {
    static constexpr bool PERM = false;
    const float* base; float* out; bf16_t* outb; float* ss;
    __device__ __forceinline__ void operator()(const f32x4 (&acc)[2][2][4][2], const Unit& u, int wr, int wc, int fr, int fq) const {
        const int col0 = u.pn * 256 + wc * 32 + 4 * fq;
#pragma unroll
        for (int ai = 0; ai < 2; ++ai)
#pragma unroll
            for (int m = 0; m < 4; ++m) { const int row = u.pm * 256 + ai * 128 + wr * 64 + m * 16 + fr; const size_t off = (size_t)row * 1024 + col0; float q = 0.f;
#pragma unroll
                for (int bj = 0; bj < 2; ++bj)
#pragma unroll
                    for (int n = 0; n < 2; ++n) { const f32x4 o = *(const f32x4*)(base + off + bj * 128 + n * 16) + acc[ai][bj][m][n];
                        *(f32x4*)(out + off + bj * 128 + n * 16) = o; q += (o[0] * o[0] + o[1] * o[1]) + (o[2] * o[2] + o[3] * o[3]);
                        if (outb) { u32x2 w; w.x = cvtpk(o[0], o[1]); w.y = cvtpk(o[2], o[3]); *(u32x2*)(outb + off + bj * 128 + n * 16) = w; } }
                q += __shfl_xor(q, 16); q += __shfl_xor(q, 32);
                if (fq == 0) atomicAdd(ss + row, q); }
    }
};
struct SchedP5 {
    const char* A; const char* B; int G, c;
    __device__ __forceinline__ bool next(int i, Unit& u) const {
        const int L = i * G + c; if (L >= 64 * 22) return false;
        pg8::tile_order(L, 64, 22, u.pm, u.pn); u.kind = 0; u.A = A + (size_t)u.pm * 256 * 1024 * 2; u.B = B + (size_t)u.pn * 256 * 1024 * 2; return true;
    }
};
struct EpiP5 {
    static constexpr bool PERM = true;
    const float* ss; bf16_t* ACT;
    __device__ __forceinline__ void operator()(const f32x4 (&acc)[2][2][4][2], const Unit& u, int wr, int wc, int fr, int fq) const {
        const int col0 = u.pn * 128 + wc * 32 + 8 * fq;
#pragma unroll
        for (int ai = 0; ai < 2; ++ai)
#pragma unroll
            for (int m = 0; m < 4; ++m) { const int row = u.pm * 256 + ai * 128 + wr * 64 + m * 16 + fr; const float r = __builtin_amdgcn_rsqf(ss[row] * (1.0f / DM) + EPS);
                float o[8];
#pragma unroll
                for (int n = 0; n < 2; ++n)
#pragma unroll
                    for (int i = 0; i < 4; ++i) { const float g = acc[ai][0][m][n][i] * r, up = acc[ai][1][m][n][i] * r; o[4 * n + i] = g * fast_sigmoid(g) * up; }
                u32x4 w; w.x = cvtpk(o[0], o[1]); w.y = cvtpk(o[2], o[3]); w.z = cvtpk(o[4], o[5]); w.w = cvtpk(o[6], o[7]);
                *(u32x4*)(ACT + (size_t)row * DFF + col0) = w; }
    }
};

namespace att {
constexpr int KBYTES = 16384, VBYTES = 16384, TILE_BYTES = KBYTES + VBYTES;
constexpr int FLAG_OFF = 2 * TILE_BYTES;
constexpr int Q_OFF = FLAG_OFF + 64, QP = 272, QW = 32 * QP;
static_assert(Q_OFF % 16 == 0 && Q_OFF + 8 * QW <= 147456, "attention LDS map");
struct TileSrc { const bf16_t* k; const bf16_t* v; unsigned vp; };

__device__ __forceinline__ void tile_dma(const TileSrc& s, LAS unsigned char* buf, int wid, int lane) {
#pragma unroll
    for (int i = 0; i < 2; ++i) {
        const int piece = wid * 2 + i;
        { const int row = piece * 4 + (lane >> 4), cc = (lane & 15) ^ (row & 15); const unsigned off = (unsigned)(row * PROJ_LD + cc * 8);
          __builtin_amdgcn_global_load_lds((const unsigned*)(s.k + off), (LAS unsigned*)(buf + piece * 1024), 16, 0, 0); }
        { const int d = piece * 8 + (lane >> 3), cc = (lane & 7) ^ ((d >> 1) & 7); const unsigned off = (unsigned)d * s.vp + (unsigned)(cc * 8);
          __builtin_amdgcn_global_load_lds((const unsigned*)(s.v + off), (LAS unsigned*)(buf + KBYTES + piece * 1024), 16, 0, 0); }
    }
}
#define ATT_DMA_WAIT() asm volatile("s_waitcnt vmcnt(0)" ::: "memory")
__device__ __forceinline__ int pi32(int r) { return (r & 0x13) | ((r & 4) << 1) | ((r & 8) >> 1); }

struct Ctx {
    const bf16_t* PROJ; bf16_t* PROJW; const bf16_t* VT; const bf16_t* METAK; const bf16_t* METAV;
    const float* subln; float lam;
    LAS unsigned char* lds; int tid, lane, wid, r, h;
};
__device__ __forceinline__ TileSrc tile_src(const Ctx& c, int b, int j, int kcol, int vrow) {
    TileSrc s;
    if (j >= 0) { s.k = c.PROJ + ((size_t)(b * SEQ + 64 * j)) * PROJ_LD + kcol; s.v = c.VT + (size_t)vrow * MROWS + b * SEQ + 64 * j; s.vp = MROWS; }
    else { s.k = c.METAK + kcol; s.v = c.METAV + (size_t)vrow * 64; s.vp = 64; }
    return s;
}
__device__ __forceinline__ int k_addr(int sub, int r, int chunk) { const int row = 32 * sub + pi32(r); return row * 256 + ((chunk ^ (row & 15)) << 4); }
__device__ __forceinline__ int v_addr(int d, int chunk) { return KBYTES + d * 128 + ((chunk ^ ((d >> 1) & 7)) << 4); }

__device__ __forceinline__ void sb_unit(const Ctx& c, int b, int hd, int qb) {
    int lane = c.lane; asm volatile("" : "+v"(lane));
    const int tid = c.tid, r = lane & 31, h = lane >> 5, wid = c.wid;
    const int tq = 256 * qb + 32 * wid + r;
    const size_t qrow = (size_t)(b * SEQ + tq) * PROJ_LD + PC_SBQ + hd * 128;
    bf16x8 qf[8];
#pragma unroll
    for (int ks = 0; ks < 8; ++ks) qf[ks] = *(const bf16x8*)(c.PROJ + qrow + 16 * ks + 8 * h);
    f32x16 o[4];
#pragma unroll
    for (int dt = 0; dt < 4; ++dt) o[dt] = f32x16{};
    float C = 1.0f;
    const int jmax = 4 * qb + 3, NT = jmax + 2;
    const int kcolx = PC_SBK + hd * 128, vrow = hd * 128;
    LAS unsigned* flags = (LAS unsigned*)(c.lds + FLAG_OFF);
    if (tid == 0) { flags[0] = 0u; flags[1] = 0u; flags[2] = 0u; }
    {   const TileSrc s = tile_src(c, b, jmax, kcolx, vrow); tile_dma(s, c.lds, wid, lane); }
    ATT_DMA_WAIT(); __syncthreads();
    const int mydiag = 4 * qb + (wid >> 1);
    bool finished = false;
    for (int t = 0; t < NT; ++t) {
        const int j = (t <= jmax) ? jmax - t : -1;
        const LAS unsigned char* cur = c.lds + (t & 1) * TILE_BYTES;
        const bool more = (t + 1 < NT);
        if (more) { const int jn = (t + 1 <= jmax) ? jmax - (t + 1) : -1; const TileSrc s = tile_src(c, b, jn, kcolx, vrow); tile_dma(s, c.lds + ((t + 1) & 1) * TILE_BYTES, wid, lane); }
        const bool wave_active = (j < 0) || (j <= mydiag);
        if (wave_active && !finished) {
            const int lim = (j >= 0) ? (tq - 64 * j) : NMETA;
#pragma unroll
            for (int sub = 1; sub >= 0; --sub) {
                f32x16 s = f32x16{};
#pragma unroll
                for (int ks = 0; ks < 8; ++ks) { const bf16x8 a = *(const LAS bf16x8*)(cur + k_addr(sub, r, 2 * ks + h)); s = __builtin_amdgcn_mfma_f32_32x32x16_bf16(a, qf[ks], s, 0, 0, 0); }
                float av[16], fv[16];
#pragma unroll
                for (int reg = 0; reg < 16; ++reg) {
                    const int kap = 32 * sub + 16 * (reg >> 3) + 8 * h + (reg & 7);
                    const float z = __builtin_fminf(__builtin_fmaxf(s[reg], -115.f), 115.f);
                    const float e = __builtin_amdgcn_exp2f(-z); const float beta = __builtin_amdgcn_rcpf(1.0f + e); const float f = e * beta;
                    const bool valid = kap < lim; av[reg] = valid ? beta : 0.f; fv[reg] = valid ? f : 1.f;
                }
                float run = 1.f;
#pragma unroll
                for (int reg = 15; reg >= 8; --reg) { av[reg] *= run; run *= fv[reg]; }
                const float GU = run; run = 1.f;
#pragma unroll
                for (int reg = 7; reg >= 0; --reg) { av[reg] *= run; run *= fv[reg]; }
                const float GL = run;
                const float GUo = __shfl_xor(GU, 32), GLo = __shfl_xor(GL, 32);
                const float pU = GU * GUo, pL = GL * GLo;
                const float preU = h ? C : C * GUo, preL = h ? C * pU : (C * pU) * GLo;
                C = C * (pU * pL);
                u32x4 pf0, pf1;
                pf0.x = cvtpk(av[0] * preL, av[1] * preL); pf0.y = cvtpk(av[2] * preL, av[3] * preL); pf0.z = cvtpk(av[4] * preL, av[5] * preL); pf0.w = cvtpk(av[6] * preL, av[7] * preL);
                pf1.x = cvtpk(av[8] * preU, av[9] * preU); pf1.y = cvtpk(av[10] * preU, av[11] * preU); pf1.z = cvtpk(av[12] * preU, av[13] * preU); pf1.w = cvtpk(av[14] * preU, av[15] * preU);
                const bf16x8 p0 = __builtin_bit_cast(bf16x8, pf0), p1 = __builtin_bit_cast(bf16x8, pf1);
#pragma unroll
                for (int dt = 0; dt < 4; ++dt) {
                    const bf16x8 v0 = *(const LAS bf16x8*)(cur + v_addr(32 * dt + r, 4 * sub + h));
                    const bf16x8 v1 = *(const LAS bf16x8*)(cur + v_addr(32 * dt + r, 4 * sub + 2 + h));
                    o[dt] = __builtin_amdgcn_mfma_f32_32x32x16_bf16(v0, p0, o[dt], 0, 0, 0);
                    o[dt] = __builtin_amdgcn_mfma_f32_32x32x16_bf16(v1, p1, o[dt], 0, 0, 0);
                }
            }
            finished = __all(C < 1e-20f);
        }
#if SB_EARLY_EXIT
        const int fw = t % 3;
        if (!finished && lane == 0) flags[fw] = 1u;
        ATT_DMA_WAIT(); __syncthreads();
        const unsigned any_live = flags[fw];
        if (tid == 0) flags[(fw + 2) % 3] = 0u;
        if (!any_live) break;
#else
        ATT_DMA_WAIT(); __syncthreads();
#endif
    }
    bf16_t* orow = c.PROJW + qrow;
#pragma unroll
    for (int dt = 0; dt < 4; ++dt)
#pragma unroll
        for (int g = 0; g < 4; ++g) { u32x2 w; w.x = cvtpk(o[dt][4 * g], o[dt][4 * g + 1]); w.y = cvtpk(o[dt][4 * g + 2], o[dt][4 * g + 3]); *(u32x2*)(orow + 32 * dt + 8 * g + 4 * h) = w; }
}

__device__ __forceinline__ void df_unit(const Ctx& c, int b, int hd, int qb) {
    int lane = c.lane; asm volatile("" : "+v"(lane));
    const int r = lane & 31, h = lane >> 5, wid = c.wid;
    const int tq = 256 * qb + 32 * wid + r;
    const size_t qrow = (size_t)(b * SEQ + tq) * PROJ_LD + PC_DFQ + hd * 128;
    LAS unsigned char* qw = c.lds + Q_OFF + wid * QW;
    {   const size_t qbase = (size_t)(b * SEQ + 256 * qb + 32 * wid) * PROJ_LD + PC_DFQ + hd * 128;
#pragma unroll
        for (int i = 0; i < 8; ++i) { const int row = 4 * i + (lane >> 4), ch = lane & 15; const u32x4 v = *(const u32x4*)(c.PROJ + qbase + (size_t)row * PROJ_LD + ch * 8); *(LAS u32x4*)(qw + row * QP + ch * 16) = v; } }
    f32x16 o[2][4];
#pragma unroll
    for (int cm = 0; cm < 2; ++cm)
#pragma unroll
        for (int dt = 0; dt < 4; ++dt) o[cm][dt] = f32x16{};
    float mref[2] = {-INFINITY, -INFINITY}, lsum[2] = {0.f, 0.f};
    const float sl2 = __builtin_amdgcn_exp2f(-(float)(hd + 1)) * LOG2E;
    const int jmax = 4 * qb + 3, NT = jmax + 2;
    const int kcolx = PC_DFK + hd * 128, vrow = 1024 + hd * 128;
    {   const TileSrc s = tile_src(c, b, jmax, kcolx, vrow); tile_dma(s, c.lds, wid, lane); }
    ATT_DMA_WAIT(); __syncthreads();
    const int mychunk = 4 * qb + (wid >> 1);
    const LAS unsigned char* qfp = qw + r * QP + 16 * h;
    for (int t = 0; t < NT; ++t) {
        const int j = (t <= jmax) ? jmax - t : -1;
        const LAS unsigned char* cur = c.lds + (t & 1) * TILE_BYTES;
        const bool more = (t + 1 < NT);
        if (more) { const int jn = (t + 1 <= jmax) ? jmax - (t + 1) : -1; const TileSrc s = tile_src(c, b, jn, kcolx, vrow); tile_dma(s, c.lds + ((t + 1) & 1) * TILE_BYTES, wid, lane); }
        if (j < 0 || j <= mychunk) {
            const float tqf = (float)(j >= 0 ? tq - 64 * j : tq + NMETA);
            const bool meta = (j < 0);
#pragma unroll 1
            for (int sub = 1; sub >= 0; --sub) {
                u32x4 pf[2][2];
#pragma unroll
                for (int cm = 0; cm < 2; ++cm) {
                    f32x16 s = f32x16{};
#pragma unroll
                    for (int ks = 0; ks < 4; ++ks) { const bf16x8 a = *(const LAS bf16x8*)(cur + k_addr(sub, r, 8 * cm + 2 * ks + h)); const bf16x8 q = *(const LAS bf16x8*)(qfp + cm * 128 + ks * 32);
                        s = __builtin_amdgcn_mfma_f32_32x32x16_bf16(a, q, s, 0, 0, 0); }
                    float mx = -INFINITY;
#pragma unroll
                    for (int reg = 0; reg < 16; ++reg) {
                        const int kap = 32 * sub + 16 * (reg >> 3) + 8 * h + (reg & 7);
                        float v = __builtin_fmaf(-sl2, __builtin_fabsf(tqf - (float)kap), s[reg]);
                        if (meta && kap >= NMETA) v = -1e30f;
                        s[reg] = v; mx = __builtin_fmaxf(mx, v);
                    }
                    mx = __builtin_fmaxf(mx, __shfl_xor(mx, 32));
                    if (__any(mx > mref[cm] + 8.0f)) {
                        const float mnew = __builtin_fmaxf(mref[cm], mx), sc = __builtin_amdgcn_exp2f(mref[cm] - mnew);
                        lsum[cm] *= sc; mref[cm] = mnew;
#pragma unroll
                        for (int dt = 0; dt < 4; ++dt) o[cm][dt] *= sc;
                    }
                    float ps = 0.f;
#pragma unroll
                    for (int reg = 0; reg < 16; ++reg) { const float p = __builtin_amdgcn_exp2f(s[reg] - mref[cm]); s[reg] = p; ps += p; }
                    lsum[cm] += ps;
                    pf[cm][0].x = cvtpk(s[0], s[1]); pf[cm][0].y = cvtpk(s[2], s[3]); pf[cm][0].z = cvtpk(s[4], s[5]); pf[cm][0].w = cvtpk(s[6], s[7]);
                    pf[cm][1].x = cvtpk(s[8], s[9]); pf[cm][1].y = cvtpk(s[10], s[11]); pf[cm][1].z = cvtpk(s[12], s[13]); pf[cm][1].w = cvtpk(s[14], s[15]);
                    __builtin_amdgcn_sched_barrier(0);
                }
#pragma unroll
                for (int dt = 0; dt < 4; ++dt) {
                    const bf16x8 v0 = *(const LAS bf16x8*)(cur + v_addr(32 * dt + r, 4 * sub + h));
                    const bf16x8 v1 = *(const LAS bf16x8*)(cur + v_addr(32 * dt + r, 4 * sub + 2 + h));
#pragma unroll
                    for (int cm = 0; cm < 2; ++cm) {
                        o[cm][dt] = __builtin_amdgcn_mfma_f32_32x32x16_bf16(v0, __builtin_bit_cast(bf16x8, pf[cm][0]), o[cm][dt], 0, 0, 0);
                        o[cm][dt] = __builtin_amdgcn_mfma_f32_32x32x16_bf16(v1, __builtin_bit_cast(bf16x8, pf[cm][1]), o[cm][dt], 0, 0, 0);
                    }
                }
            }
        }
        ATT_DMA_WAIT(); __syncthreads();
    }
    const float L0 = lsum[0] + __shfl_xor(lsum[0], 32), L1 = lsum[1] + __shfl_xor(lsum[1], 32);
    const float i0 = 1.0f / L0, i1 = c.lam / L1;
    float ss = 0.f;
#pragma unroll
    for (int dt = 0; dt < 4; ++dt)
#pragma unroll
        for (int reg = 0; reg < 16; ++reg) { const float v = o[0][dt][reg] * i0 - o[1][dt][reg] * i1; o[0][dt][reg] = v; ss += v * v; }
    ss += __shfl_xor(ss, 32);
    __builtin_amdgcn_sched_barrier(0);
    const float rs = __builtin_amdgcn_rsqf(ss * (1.0f / 128.0f) + EPS) * 0.8f;
    bf16_t* orow = c.PROJW + qrow;
#pragma unroll
    for (int dt = 0; dt < 4; ++dt)
#pragma unroll
        for (int g = 0; g < 4; ++g) { const int d0 = 32 * dt + 8 * g + 4 * h; const f32x4 gn = *(const f32x4*)(c.subln + d0);
            u32x2 w; w.x = cvtpk(o[0][dt][4 * g] * rs * gn[0], o[0][dt][4 * g + 1] * rs * gn[1]); w.y = cvtpk(o[0][dt][4 * g + 2] * rs * gn[2], o[0][dt][4 * g + 3] * rs * gn[3]);
            *(u32x2*)(orow + d0) = w; }
}
}


#define XB_TMO      128
#define XB_XCNT(j)  (256  + 64 * (j))
#define XB_XSUB(j)  (1280 + 64 * (j))
#define XB_XGEN(j)  (2304 + 64 * (j))
#define XB_TOP      3328
#define XB_TOPGEN   3392
#define XCD_BAR_WORDS 3456
#define XB_SPIN_CAP (1u << 22)
__device__ __forceinline__ unsigned xb_ld(unsigned* p)              { return __hip_atomic_load(p, __ATOMIC_RELAXED, __HIP_MEMORY_SCOPE_AGENT); }
__device__ __forceinline__ unsigned xb_add(unsigned* p, unsigned v) { return __hip_atomic_fetch_add(p, v, __ATOMIC_RELAXED, __HIP_MEMORY_SCOPE_AGENT); }
__device__ __forceinline__ unsigned xb_xcc_id() { return (unsigned)__builtin_amdgcn_s_getreg((3 << 11) | 20) & 0xFu; }
#define XB_SPIN(cond, bar) do { unsigned _sp = 0; while (cond) { __builtin_amdgcn_s_sleep(1); \
    if ((++_sp & 255u) == 0u) { if (xb_ld(&(bar)[XB_TMO])) break; if (_sp > XB_SPIN_CAP) { atomicAdd(&(bar)[XB_TMO], 1u); break; } } } } while (0)
struct XcdBarrier { unsigned* bar; unsigned x; volatile LAS unsigned* st; };
__device__ __forceinline__ XcdBarrier xcd_barrier_post(unsigned* bar, volatile LAS unsigned* st) {
    XcdBarrier b; b.bar = bar; b.x = xb_xcc_id(); b.st = st;
    if (threadIdx.x == 0) (void)xb_add(&bar[XB_XCNT(b.x)], 1u);
    return b;
}
__device__ __forceinline__ void xcd_barrier_complete(unsigned* bar, unsigned x, unsigned& nloc, unsigned& nx) {
    const unsigned G = gridDim.x * gridDim.y * gridDim.z;
    unsigned sum, cnt, mine, sp = 0u;
    for (;;) {
        sum = 0u; cnt = 0u; mine = 0u;
#pragma unroll
        for (unsigned j = 0; j < 16; ++j) { const unsigned c = xb_ld(&bar[XB_XCNT(j)]); sum += c; cnt += (c > 0u) ? 1u : 0u; mine = (j == x) ? c : mine; }
        if (sum == G) break;
        __builtin_amdgcn_s_sleep(1);
        if ((++sp & 255u) == 0u) { if (xb_ld(&bar[XB_TMO])) break; if (sp > XB_SPIN_CAP) { atomicAdd(&bar[XB_TMO], 1u); break; } }
    }
    nloc = mine > 0u ? mine : 1u; nx = cnt > 0u ? cnt : 1u;
}
__device__ __forceinline__ void xcd_barrier(const XcdBarrier& b) {
    asm volatile("s_waitcnt vmcnt(0)" ::: "memory");
    __syncthreads();
    if (threadIdx.x == 0) {
        unsigned* bar = b.bar;
        __builtin_amdgcn_s_waitcnt(0);
        unsigned nloc = b.st[0], nx = b.st[1];
        if (nloc == 0u) { xcd_barrier_complete(bar, b.x, nloc, nx); b.st[0] = nloc; b.st[1] = nx; }
        const unsigned old = xb_add(&bar[XB_XSUB(b.x)], 1u);
        const unsigned gen = old / nloc;
        if (old + 1u == (gen + 1u) * nloc) {
            __builtin_amdgcn_fence(__ATOMIC_RELEASE, "agent");
            asm volatile("s_waitcnt vmcnt(0)" ::: "memory");
            const unsigned og = xb_add(&bar[XB_TOP], 1u);
            const unsigned tg = og / nx;
            if (og + 1u == (tg + 1u) * nx) xb_add(&bar[XB_TOPGEN], 1u);
            else XB_SPIN(xb_ld(&bar[XB_TOPGEN]) == tg, bar);
            __builtin_amdgcn_fence(__ATOMIC_ACQUIRE, "agent");
            xb_add(&bar[XB_XGEN(b.x)], 1u);
            asm volatile("s_waitcnt vmcnt(0)" ::: "memory");
        } else {
            XB_SPIN(xb_ld(&bar[XB_XGEN(b.x)]) == gen, bar);
            __builtin_amdgcn_fence(__ATOMIC_ACQUIRE, "agent");
            asm volatile("s_waitcnt vmcnt(0)" ::: "memory");
        }
    }
    __syncthreads();
}

__device__ __forceinline__ void transpose_item(const float* W, int ldw, int k0, int n0, bf16_t* WT, int ldwt, int drow0, int dcol0, int dup_off, float scale, const float* kscale, LAS float* scr, int lane) {
#pragma unroll 8
    for (int i = 0; i < 32; ++i) { const int kk = 2 * i + (lane >> 5); float v = W[(size_t)(k0 + kk) * ldw + n0 + (lane & 31)] * scale; if (kscale) v *= kscale[k0 + kk]; scr[kk * 33 + (lane & 31)] = v; }
    asm volatile("s_waitcnt lgkmcnt(0)" ::: "memory");
    const int cc = lane & 7;
#pragma unroll
    for (int jj = 0; jj < 4; ++jj) { const int n = (lane >> 3) + 8 * jj; const LAS float* s = scr + (8 * cc) * 33 + n;
        u32x4 ov; ov.x = cvtpk(s[0 * 33], s[1 * 33]); ov.y = cvtpk(s[2 * 33], s[3 * 33]); ov.z = cvtpk(s[4 * 33], s[5 * 33]); ov.w = cvtpk(s[6 * 33], s[7 * 33]);
        bf16_t* dst = WT + (size_t)(drow0 + n) * ldwt + dcol0 + k0 + 8 * cc;
        *(u32x4*)dst = ov; if (dup_off) *(u32x4*)(dst + dup_off) = ov; }
    asm volatile("s_waitcnt lgkmcnt(0)" ::: "memory");
}

constexpr int LDS_BYTES = 147456, LDS_MISC_OFF = LDS_BYTES - 64;
struct Args { const float* in[19]; float* out; unsigned char* ws; int ph_lo, ph_hi; };

__global__ void __launch_bounds__(NTHREADS, 2) fwd_kernel(Args args) {
    extern __shared__ __attribute__((aligned(16))) unsigned char lds_raw[];
    LAS unsigned char* lds = (LAS unsigned char*)lds_raw;
    const int tid = threadIdx.x, lane = tid & 63, wid = __builtin_amdgcn_readfirstlane(tid >> 6);
    const int G = gridDim.x, bx = blockIdx.x;
    unsigned char* ws = args.ws;
    const float* x = args.in[0];
    bf16_t* W1T = (bf16_t*)(ws + WS_W1T); bf16_t* XN = (bf16_t*)(ws + WS_XN); bf16_t* PROJ = (bf16_t*)(ws + WS_PROJ); bf16_t* GATES = (bf16_t*)(ws + WS_GATES);
    bf16_t* METAK = (bf16_t*)(ws + WS_METAK); bf16_t* METAV = (bf16_t*)(ws + WS_METAV);
    bf16_t* WBR = (bf16_t*)(ws + WS_WBR); bf16_t* WOUT2 = (bf16_t*)(ws + WS_WOUT2); bf16_t* WFFN = (bf16_t*)(ws + WS_WFFN); bf16_t* WDOWN = (bf16_t*)(ws + WS_WDOWN);
    bf16_t* H1B = (bf16_t*)(ws + WS_H1B); bf16_t* ACT = (bf16_t*)(ws + WS_ACT); float* H1 = (float*)(ws + WS_H1);
    float* SS1 = (float*)(ws + CTL_SS1); float* SS2 = (float*)(ws + CTL_SS2);
    bf16_t* VT = (bf16_t*)args.out; bf16_t* Y = (bf16_t*)args.out;
    const int gw = bx * NWAVES + wid, NGW = G * NWAVES;
    const int lo = args.ph_lo, hi = args.ph_hi;
#define IN(k) (lo <= (k) && (k) < hi)
#if MK_N_LAUNCHES == 1
    volatile LAS unsigned* bar_st = (volatile LAS unsigned*)(lds + LDS_MISC_OFF);
    if (tid < 2) bar_st[tid] = 0u;
    __syncthreads();
    const XcdBarrier gbar = xcd_barrier_post((unsigned*)(ws + CTL_BAR), bar_st);
    if (args.ph_lo < 0) cg::this_grid().sync();
#define GRID_BAR() xcd_barrier(gbar)
#else
#define GRID_BAR() do {} while (0)
#endif

    if (IN(0)) {
        LAS float* scr = (LAS float*)(lds + wid * 16384);
        const float* w_in = args.in[3]; const float* w_gate = args.in[4];
        const float cq_sb = LOG2E * 0.08838834764831845f, cq_df = LOG2E * 0.125f;
        for (int it = gw; it < 16 * 256; it += NGW) {
            const int kb = it >> 8, nb = it & 255, blk = nb >> 5, nin = (nb & 31) * 32;
            const float* src; int ldw, n0; float sc = 1.f;
            switch (blk) {
                case 0: src = w_in; ldw = 6144; n0 = 0 + nin; sc = cq_sb; break;
                case 1: src = w_in; ldw = 6144; n0 = 1024 + nin; break;
                case 2: src = w_in; ldw = 6144; n0 = 3072 + nin; sc = cq_df; break;
                case 3: src = w_in; ldw = 6144; n0 = 4096 + nin; break;
                case 4: src = w_gate; ldw = 2048; n0 = nin; break;
                case 5: src = w_gate; ldw = 2048; n0 = 1024 + nin; break;
                case 6: src = w_in; ldw = 6144; n0 = 2048 + nin; break;
                default: src = w_in; ldw = 6144; n0 = 5120 + nin; break;
            }
            transpose_item(src, ldw, kb * 64, n0, W1T, 1024, nb * 32, 0, 0, sc, nullptr, scr, lane);
        }
        {   const float* g = args.in[2];
            f32x4 gv[4];
#pragma unroll
            for (int jj = 0; jj < 4; ++jj) gv[jj] = *((const f32x4*)g + lane + 64 * jj);
            for (int m = gw; m < MROWS; m += NGW) {
                const f32x4* xr = (const f32x4*)(x + (size_t)m * DM) + lane; f32x4 v[4]; float s = 0.f;
#pragma unroll
                for (int jj = 0; jj < 4; ++jj) { v[jj] = xr[64 * jj]; s += (v[jj].x * v[jj].x + v[jj].y * v[jj].y) + (v[jj].z * v[jj].z + v[jj].w * v[jj].w); }
                const float rstd = __builtin_amdgcn_rsqf(wave_sum(s) * (1.0f / DM) + EPS);
                u32x2* o8 = (u32x2*)(XN + (size_t)m * DM) + lane;
#pragma unroll
                for (int jj = 0; jj < 4; ++jj) { u32x2 w; w.x = cvtpk(v[jj].x * rstd * gv[jj].x, v[jj].y * rstd * gv[jj].y); w.y = cvtpk(v[jj].z * rstd * gv[jj].z, v[jj].w * rstd * gv[jj].w); o8[64 * jj] = w; }
            }
        }
        if (bx < 32) {
            __syncthreads();
            LAS float* xm = (LAS float*)lds;
            LAS float* part = (LAS float*)(lds + 65536);
            const float* meta = args.in[1]; const float* g = args.in[2];
            for (int rr = 0; rr < 2; ++rr) { const int row = 2 * wid + rr; const f32x4* xr = (const f32x4*)(meta + (size_t)row * DM) + lane; f32x4 v[4]; float s = 0.f;
#pragma unroll
                for (int jj = 0; jj < 4; ++jj) { v[jj] = xr[64 * jj]; s += (v[jj].x * v[jj].x + v[jj].y * v[jj].y) + (v[jj].z * v[jj].z + v[jj].w * v[jj].w); }
                const float rstd = __builtin_amdgcn_rsqf(wave_sum(s) * (1.0f / DM) + EPS);
#pragma unroll
                for (int jj = 0; jj < 4; ++jj) { const f32x4 gg = *((const f32x4*)g + lane + 64 * jj); f32x4 w = v[jj] * rstd * gg; *(LAS f32x4*)(xm + row * 1024 + 4 * (lane + 64 * jj)) = w; } }
            __syncthreads();
            const int cl = tid & 127, kq = tid >> 7, blk = bx >> 3, col = (bx & 7) * 128 + cl;
            const int srcc = (blk == 0 ? 1024 : blk == 1 ? 2048 : blk == 2 ? 4096 : 5120) + col;
            float acc[16];
#pragma unroll
            for (int i = 0; i < 16; ++i) acc[i] = 0.f;
            for (int k = kq * 256; k < kq * 256 + 256; ++k) { const float w = w_in[(size_t)k * 6144 + srcc];
#pragma unroll
                for (int i = 0; i < 16; ++i) acc[i] = __builtin_fmaf(xm[i * 1024 + k], w, acc[i]); }
#pragma unroll
            for (int i = 0; i < 16; ++i) part[(kq * 16 + i) * 128 + cl] = acc[i];
            __syncthreads();
            if (blk == 0 || blk == 2) {
                const int row = tid >> 5, c4 = (tid & 31) * 4; float v[4];
#pragma unroll
                for (int i = 0; i < 4; ++i) v[i] = (part[(0 * 16 + row) * 128 + c4 + i] + part[(1 * 16 + row) * 128 + c4 + i]) + (part[(2 * 16 + row) * 128 + c4 + i] + part[(3 * 16 + row) * 128 + c4 + i]);
                const int dcol = (blk == 2 ? PC_DFK : PC_SBK) + (bx & 7) * 128 + c4;
                u32x2 w; w.x = cvtpk(v[0], v[1]); w.y = cvtpk(v[2], v[3]); *(u32x2*)(METAK + (size_t)row * PROJ_LD + dcol) = w;
                const u32x2 z = {0u, 0u};
#pragma unroll
                for (int i = 0; i < 3; ++i) *(u32x2*)(METAK + (size_t)(16 + row + 16 * i) * PROJ_LD + dcol) = z;
            } else if (tid < 128) {
                float v[16];
#pragma unroll
                for (int i = 0; i < 16; ++i) v[i] = (part[(0 * 16 + i) * 128 + cl] + part[(1 * 16 + i) * 128 + cl]) + (part[(2 * 16 + i) * 128 + cl] + part[(3 * 16 + i) * 128 + cl]);
                bf16_t* dst = METAV + (size_t)((blk == 3 ? 1024 : 0) + col) * 64;
                u32x4 w0, w1; const u32x4 z = {0u, 0u, 0u, 0u};
                w0.x = cvtpk(v[0], v[1]); w0.y = cvtpk(v[2], v[3]); w0.z = cvtpk(v[4], v[5]); w0.w = cvtpk(v[6], v[7]);
                w1.x = cvtpk(v[8], v[9]); w1.y = cvtpk(v[10], v[11]); w1.z = cvtpk(v[12], v[13]); w1.w = cvtpk(v[14], v[15]);
                *(u32x4*)(dst) = w0; *(u32x4*)(dst + 8) = w1;
#pragma unroll
                for (int i = 2; i < 8; ++i) *(u32x4*)(dst + 8 * i) = z;
            }
        }
        if (IN(1)) GRID_BAR();
    }

    if (IN(1)) {
        SchedP1 S{(const char*)XN, (const char*)W1T, G, bx};
        EpiP1 E{PROJ, GATES, VT, args.in[5]};
        pg8::gemm_phase<EpiP1, SchedP1, true>(lds, 1024, 1024, 1024, S, E);
        if (IN(2)) GRID_BAR();
    }

    if (IN(2)) {
        {   LAS float* scr = (LAS float*)(lds + wid * 16384);
            const float* w_br_sb = args.in[11]; const float* w_br_df = args.in[12]; const float* w_out = args.in[13]; const float* gffn = args.in[14];
            const float* w_fg = args.in[15]; const float* w_fu = args.in[16]; const float* w_fd = args.in[17];
            constexpr int I_BR = 16 * 32, I_FFN = 16 * 176, I_DN = 44 * 32, I_ALL = 3 * I_BR + I_FFN + I_DN;
            for (int it0 = gw; it0 < I_ALL; it0 += NGW) {
                int it = it0;
                if (it < I_BR) { transpose_item(w_br_sb, 1024, (it >> 5) * 64, (it & 31) * 32, WBR, 1024, (it & 31) * 32, 0, 0, 1.f, nullptr, scr, lane); continue; } it -= I_BR;
                if (it < I_BR) { transpose_item(w_br_df, 1024, (it >> 5) * 64, (it & 31) * 32, WBR, 1024, 1024 + (it & 31) * 32, 0, 0, 1.f, nullptr, scr, lane); continue; } it -= I_BR;
                if (it < I_BR) { transpose_item(w_out, 1024, (it >> 5) * 64, (it & 31) * 32, WOUT2, 2048, (it & 31) * 32, 0, 1024, 1.f, nullptr, scr, lane); continue; } it -= I_BR;
                if (it < I_FFN) { const int kb = it / 176, nb = it % 176, R = nb * 32, p = R >> 8, rr = R & 255;
                    const float* src = (rr < 128) ? w_fg : w_fu; const int n0 = 128 * p + (rr & 127);
                    transpose_item(src, DFF, kb * 64, n0, WFFN, 1024, R, 0, 0, 1.f, gffn, scr, lane); continue; } it -= I_FFN;
                transpose_item(w_fd, 1024, (it >> 5) * 64, (it & 31) * 32, WDOWN, DFF, (it & 31) * 32, 0, 0, 1.f, nullptr, scr, lane);
            }
        }
        __syncthreads();
        att::Ctx c; c.PROJ = PROJ; c.PROJW = PROJ; c.VT = VT; c.METAK = METAK; c.METAV = METAV; c.subln = args.in[10]; c.lds = lds; c.tid = tid; c.lane = lane; c.wid = wid; c.r = lane & 31; c.h = lane >> 5;
        {   const float a1 = args.in[6][lane] * args.in[7][lane], a2 = args.in[8][lane] * args.in[9][lane];
            c.lam = __expf(wave_sum(a1)) - __expf(wave_sum(a2)) + 0.2f; }
        LAS unsigned* flags = (LAS unsigned*)(lds + att::FLAG_OFF);
        if (tid < 8) flags[tid] = 0u;
        __syncthreads();
        unsigned* queue = (unsigned*)(ws + CTL_QUEUE);
        for (;;) {
            if (tid == 0) flags[4] = atomicAdd(queue, 1u);
            __syncthreads();
            const unsigned u = flags[4];
            __syncthreads();
            if (u >= 1024u) break;
            if (u < 512u) {
#ifndef NO_DF
                const int qb = 31 - (int)(u >> 4), hb = (int)(u & 15), hd = 7 - (hb >> 1), b = hb & 1; att::df_unit(c, b, hd, qb);
#endif
            }
            else {
#ifndef NO_SB
                const unsigned v = u - 512u; const int qb = 31 - (int)(v >> 4), hb = (int)(v & 15), hd = hb >> 1, b = hb & 1; att::sb_unit(c, b, hd, qb);
#endif
            }
        }
        if (IN(3)) GRID_BAR();
    }

    if (IN(3)) {
        SchedP3 S{(const char*)PROJ, (const char*)WBR, G, bx};
        EpiP3 E{GATES, Y};
        pg8::gemm_phase<EpiP3, SchedP3, true>(lds, 1024, PROJ_LD, 1024, S, E);
        if (IN(4)) GRID_BAR();
    }

    if (IN(4)) {
        SchedN1024 S{(const char*)Y, (const char*)WOUT2, (size_t)2048 * 2, (size_t)2048 * 2, G, bx};
        EpiRes E{x, H1, H1B, SS1};
        pg8::gemm_phase<EpiRes, SchedN1024, false>(lds, 2048, 2048, 2048, S, E);
        if (IN(5)) GRID_BAR();
    }

    if (IN(5)) {
        SchedP5 S{(const char*)H1B, (const char*)WFFN, G, bx};
        EpiP5 E{SS1, ACT};
        pg8::gemm_phase<EpiP5, SchedP5, true>(lds, 1024, 1024, 1024, S, E);
        if (IN(6)) GRID_BAR();
    }

    if (IN(6)) {
        SchedN1024 S{(const char*)ACT, (const char*)WDOWN, (size_t)DFF * 2, (size_t)DFF * 2, G, bx};
        EpiRes E{H1, args.out, nullptr, SS2};
        pg8::gemm_phase<EpiRes, SchedN1024, false>(lds, DFF, DFF, DFF, S, E);
        if (IN(7)) GRID_BAR();
    }

    if (IN(7)) {
        const float* g = args.in[18];
        f32x4 gv[4];
#pragma unroll
        for (int jj = 0; jj < 4; ++jj) gv[jj] = *((const f32x4*)g + lane + 64 * jj);
        for (int m = gw; m < MROWS; m += NGW) {
            f32x4* xr = (f32x4*)(args.out + (size_t)m * DM) + lane; const float rstd = __builtin_amdgcn_rsqf(SS2[m] * (1.0f / DM) + EPS);
#pragma unroll
            for (int jj = 0; jj < 4; ++jj) { f32x4 v = xr[64 * jj]; v = v * rstd * gv[jj]; xr[64 * jj] = v; }
        }
    }
#undef IN
}

extern "C" void kernel_launch(void* const* d_in, const int* in_sizes, int n_in, void* d_out, int out_size, void* d_ws, size_t ws_size, hipStream_t stream) {
    static int grid = 0;
    if (grid == 0) {
        if (n_in != 19 || out_size != MROWS * DM || ws_size < WS_END) { fprintf(stderr, "kernel_launch: unexpected shapes (n_in %d out %d ws %zu)\n", n_in, out_size, ws_size); grid = -1; return; }
        int dev = 0, cus = 0, per_cu = 0;
        hipGetDevice(&dev); hipDeviceGetAttribute(&cus, hipDeviceAttributeMultiprocessorCount, dev);
        if (hipFuncSetAttribute((const void*)fwd_kernel, hipFuncAttributeMaxDynamicSharedMemorySize, LDS_BYTES) != hipSuccess) { fprintf(stderr, "kernel_launch: hipFuncSetAttribute failed\n"); grid = -1; return; }
        if (hipOccupancyMaxActiveBlocksPerMultiprocessor(&per_cu, (const void*)fwd_kernel, NTHREADS, LDS_BYTES) != hipSuccess || per_cu < 1) { fprintf(stderr, "kernel_launch: occupancy query says %d\n", per_cu); per_cu = 1; }
        (void)hipGetLastError();
        grid = cus * 1;
    }
    if (grid < 0) return;
    (void)hipMemsetAsync((char*)d_ws + WS_CTL, 0, CTL_BYTES, stream);
    Args a{};
    for (int i = 0; i < 19; ++i) a.in[i] = (const float*)d_in[i];
    a.out = (float*)d_out; a.ws = (unsigned char*)d_ws;
#if MK_N_LAUNCHES == 1
    a.ph_lo = 0; a.ph_hi = 8;
    void* kargs[] = {&a};
    hipError_t e = hipLaunchCooperativeKernel((const void*)fwd_kernel, dim3(grid), dim3(NTHREADS), kargs, LDS_BYTES, stream);
    if (e != hipSuccess) fprintf(stderr, "kernel_launch: cooperative launch failed: %s (grid %d)\n", hipGetErrorString(e), grid);
#else
    for (int p = 0; p < 8; ++p) { a.ph_lo = p; a.ph_hi = p + 1; hipLaunchKernelGGL(fwd_kernel, dim3(grid), dim3(NTHREADS), LDS_BYTES, stream, a); }
#endif
}
```

```cpp
#include <hip/hip_runtime.h>
#include <hip/hip_cooperative_groups.h>
#include <cstdio>
#include <cstdint>
namespace cg = cooperative_groups;

#ifndef MK_N_LAUNCHES
#define MK_N_LAUNCHES 1
#endif
#ifndef SB_EARLY_EXIT
#define SB_EARLY_EXIT 1
#endif

#define LAS __attribute__((address_space(3)))
typedef unsigned short bf16_t;
typedef short bf16x8 __attribute__((ext_vector_type(8)));
typedef float f32x4 __attribute__((ext_vector_type(4)));
typedef float f32x16 __attribute__((ext_vector_type(16)));
typedef unsigned u32x4 __attribute__((ext_vector_type(4)));
typedef unsigned u32x2 __attribute__((ext_vector_type(2)));
typedef float f32x2_t __attribute__((ext_vector_type(2)));
typedef __bf16 bf16x2_t __attribute__((ext_vector_type(2)));

constexpr int SEQ = 8192, DM = 1024, MROWS = 2 * SEQ, NMETA = 16, DFF = 2816;
constexpr float EPS = 1e-6f;
constexpr float LOG2E = 1.4426950408889634f;
constexpr int NWAVES = 8, NTHREADS = 512;
constexpr int PROJ_LD = 4096;
constexpr int PC_SBQ = 0, PC_SBK = 1024, PC_DFQ = 2048, PC_DFK = 3072;

constexpr size_t MiB = 1u << 20;
constexpr size_t WS_CTL = 0, CTL_BYTES = 1 * MiB;
constexpr size_t CTL_QUEUE = 256;
constexpr size_t CTL_NK = 1024;
constexpr size_t CTL_BAR = 64 * 1024;
constexpr size_t CTL_SS1 = 256 * 1024, CTL_SS2 = 512 * 1024;
constexpr size_t WS_W1T = 1 * MiB;
constexpr size_t WS_METAK = 17 * MiB;
constexpr size_t WS_METAV = WS_METAK + 512 * 1024;
constexpr size_t WS_XN = 18 * MiB;
constexpr size_t WS_WBR = 18 * MiB;
constexpr size_t WS_WOUT2 = 22 * MiB;
constexpr size_t WS_WFFN = 26 * MiB;
constexpr size_t WS_WDOWN = 38 * MiB;
constexpr size_t WS_PROJ = 50 * MiB;
constexpr size_t WS_H1B = 50 * MiB;
constexpr size_t WS_ACT = 82 * MiB;
constexpr size_t WS_GATES = 178 * MiB;
constexpr size_t WS_H1 = 178 * MiB;
constexpr size_t WS_END = 242 * MiB;

__device__ __forceinline__ unsigned cvtpk(float lo, float hi) { f32x2_t v = {lo, hi}; bf16x2_t b = __builtin_convertvector(v, bf16x2_t); return __builtin_bit_cast(unsigned, b); }
__device__ __forceinline__ float bf2f(unsigned short b) { return __builtin_bit_cast(float, (unsigned)b << 16); }
__device__ __forceinline__ float wave_sum(float v) {
#pragma unroll
    for (int o = 1; o < 64; o <<= 1) v += __shfl_xor(v, o);
    return v;
}
__device__ __forceinline__ float fast_sigmoid(float x) { return __builtin_amdgcn_rcpf(1.0f + __builtin_amdgcn_exp2f(-x * LOG2E)); }

namespace pg8 {
constexpr int BM = 256, BK = 64, HALF = 128, HTB = HALF * BK * 2, STAGE_BYTES = 8 * HTB, NXCD = 8, WGM = 8;
__host__ __device__ __forceinline__ int lds_byte(int r, int c) { const int st = (r >> 4) * 2 + (c >> 5), rr = r & 15, cc = c & 31, ob = rr * 64 + cc * 2; return st * 1024 + (ob ^ (((ob >> 9) & 1) << 5)); }
__host__ __device__ __forceinline__ void stage_rc(int b, int& R, int& C) { const int st = b / 1024, sb = b % 1024, swz = sb ^ (((sb >> 9) & 1) << 5); R = (st >> 1) * 16 + swz / 64; C = (st & 1) * 32 + (swz % 64) / 2; }
__host__ __device__ __forceinline__ int perm32(int rho) { const int n = rho >> 4, i = rho & 15; return 8 * (i >> 2) + 4 * n + (i & 3); }

struct Unit { int pm, pn, kind; const char* A; const char* B; };
__device__ __forceinline__ void tile_order(int wgid, int nM, int nN, int& pm, int& pn) {
    const int nwg = nM * nN;
    { const int q = nwg / NXCD, r = nwg % NXCD, xcd = wgid % NXCD, off = wgid / NXCD; wgid = (xcd < r ? xcd * (q + 1) : r * (q + 1) + (xcd - r) * q) + off; }
    const int nig = WGM * nN, gid = wgid / nig, fm = gid * WGM, gsz = (nM - fm) < WGM ? (nM - fm) : WGM;
    pm = fm + ((wgid % nig) % gsz); pn = (wgid % nig) / gsz;
}
template <class Epi, class Sched, bool ALIGN_EPI>
__device__ __forceinline__ void gemm_phase(LAS unsigned char* lds, const int K, const int lda, const int ldb, const Sched& S, const Epi& E) {
    const int tid = threadIdx.x, wid = __builtin_amdgcn_readfirstlane(tid >> 6), lane = tid & 63, wr = wid >> 2, wc = wid & 3, fr = lane & 15, fq = lane >> 4;
    const int nt = K / BK;
    unsigned voffA[2], voffB[2];
#pragma unroll
    for (int i = 0; i < 2; ++i) { int R, C; stage_rc(tid * 16 + i * 8192, R, C); const int Rb = Epi::PERM ? ((R & ~31) + perm32(R & 31)) : R;
        voffA[i] = (unsigned)(R * lda + C) * 2u; voffB[i] = (unsigned)(Rb * ldb + C) * 2u; }
    const size_t kstep = (size_t)(BK * 2);
    const size_t hstepA = (size_t)HALF * lda * 2, hstepB = (size_t)HALF * ldb * 2;
    const unsigned ldsw = (unsigned)wid * 1024u;
    const int aoff = lds_byte(wr * 64 + fr, fq * 8), boff = lds_byte(wc * 32 + fr, fq * 8);
#define PG8_SA(b, h) (((b) * 2 + (h)) * HTB)
#define PG8_SB(b, h) ((4 + (b) * 2 + (h)) * HTB)
#define PG8_STAGE(bufoff, gbase, voff) do { _Pragma("unroll") for (int _i = 0; _i < 2; ++_i) \
        __builtin_amdgcn_global_load_lds((const unsigned*)((const char*)(gbase) + (voff)[_i]), (LAS unsigned*)(lds + (bufoff) + ldsw + _i * 8192), 16, 0, 0); } while (0)
#define PG8_LDA(dst, b, h) do { _Pragma("unroll") for (int m = 0; m < 4; ++m) _Pragma("unroll") for (int k = 0; k < 2; ++k) dst[m][k] = *(const LAS bf16x8*)(lds + PG8_SA(b, h) + aoff + m * 2048 + k * 1024); } while (0)
#define PG8_LDB(dst, b, h) do { _Pragma("unroll") for (int n = 0; n < 2; ++n) _Pragma("unroll") for (int k = 0; k < 2; ++k) dst[n][k] = *(const LAS bf16x8*)(lds + PG8_SB(b, h) + boff + n * 2048 + k * 1024); } while (0)
#define PG8_MMA(ai, bj, At, Bt) do { __builtin_amdgcn_s_setprio(1); _Pragma("unroll") for (int m = 0; m < 4; ++m) _Pragma("unroll") for (int n = 0; n < 2; ++n) _Pragma("unroll") for (int k = 0; k < 2; ++k) \
        acc[ai][bj][m][n] = __builtin_amdgcn_mfma_f32_16x16x32_bf16(Bt[n][k], At[m][k], acc[ai][bj][m][n], 0, 0, 0); __builtin_amdgcn_s_setprio(0); } while (0)
#define PG8_WAIT_V(n) asm volatile("s_waitcnt vmcnt(" #n ")" ::: "memory")
#define PG8_WAIT_L(n) asm volatile("s_waitcnt lgkmcnt(" #n ")" ::: "memory")
#define PG8_BAR __builtin_amdgcn_s_barrier()
#define PG8_SCHED __builtin_amdgcn_sched_barrier(0)
    Unit cur, nxt; int ui = 0;
    if (!S.next(0, cur)) return;
    f32x4 acc[2][2][4][2];
#pragma unroll
    for (int a = 0; a < 2; ++a)
#pragma unroll
        for (int b = 0; b < 2; ++b)
#pragma unroll
            for (int m = 0; m < 4; ++m)
#pragma unroll
                for (int n = 0; n < 2; ++n) acc[a][b][m][n] = (f32x4){0.f, 0.f, 0.f, 0.f};
    bf16x8 At[4][2], B0[2][2], B1[2][2];
    const char* cA = cur.A; const char* cB = cur.B;
    PG8_STAGE(PG8_SB(0, 0), cB, voffB); PG8_STAGE(PG8_SB(0, 1), cB + hstepB, voffB); PG8_STAGE(PG8_SA(0, 0), cA, voffA); PG8_STAGE(PG8_SA(0, 1), cA + hstepA, voffA);
    if (wr == 1) PG8_BAR;
    PG8_WAIT_V(2); PG8_BAR;
    PG8_STAGE(PG8_SB(1, 0), cB + kstep, voffB); PG8_STAGE(PG8_SA(1, 0), cA + kstep, voffA); PG8_STAGE(PG8_SB(1, 1), cB + hstepB + kstep, voffB);
    PG8_WAIT_V(6); PG8_BAR;
    for (;;) {
        const bool has_next = S.next(ui + 1, nxt);
        const char* nA = has_next ? nxt.A : cA; const char* nB = has_next ? nxt.B : cB;
        for (int t = 0; t < nt; t += 2) {
            const bool last = (t == nt - 2);
            const char* a1 = cA + (size_t)(t + 1) * kstep;
            const char* a2 = last ? nA : cA + (size_t)(t + 2) * kstep; const char* b2 = last ? nB : cB + (size_t)(t + 2) * kstep;
            const char* a3 = a2 + kstep; const char* b3 = b2 + kstep;
            PG8_LDB(B0, 0, 0); PG8_LDB(B1, 0, 1); PG8_SCHED; PG8_LDA(At, 0, 0); PG8_STAGE(PG8_SA(1, 1), a1 + hstepA, voffA);
            PG8_WAIT_V(8); PG8_WAIT_L(0); PG8_BAR; PG8_MMA(0, 0, At, B0); PG8_MMA(0, 1, At, B1); PG8_BAR; PG8_SCHED;
            PG8_LDA(At, 0, 1); PG8_STAGE(PG8_SB(0, 0), b2, voffB); PG8_STAGE(PG8_SB(0, 1), b2 + hstepB, voffB); PG8_STAGE(PG8_SA(0, 0), a2, voffA);
            PG8_WAIT_V(8); PG8_WAIT_L(0); PG8_BAR; PG8_MMA(1, 0, At, B0); PG8_MMA(1, 1, At, B1); PG8_BAR; PG8_SCHED;
            PG8_LDB(B0, 1, 0); PG8_LDB(B1, 1, 1); PG8_SCHED; PG8_LDA(At, 1, 0); PG8_STAGE(PG8_SA(0, 1), a2 + hstepA, voffA);
            PG8_WAIT_V(8); PG8_WAIT_L(0); PG8_BAR; PG8_MMA(0, 0, At, B0); PG8_MMA(0, 1, At, B1); PG8_BAR; PG8_SCHED;
            PG8_LDA(At, 1, 1); PG8_STAGE(PG8_SB(1, 0), b3, voffB); PG8_STAGE(PG8_SB(1, 1), b3 + hstepB, voffB); PG8_STAGE(PG8_SA(1, 0), a3, voffA);
            PG8_WAIT_V(8); PG8_WAIT_L(0); PG8_BAR; PG8_MMA(1, 0, At, B0); PG8_MMA(1, 1, At, B1); PG8_BAR; PG8_SCHED;
        }
        if constexpr (ALIGN_EPI) { if (wr == 0) PG8_BAR; }
        E(acc, cur, wr, wc, fr, fq);
        if (!has_next) break;
#pragma unroll
        for (int a = 0; a < 2; ++a)
#pragma unroll
            for (int b = 0; b < 2; ++b)
#pragma unroll
                for (int m = 0; m < 4; ++m)
#pragma unroll
                    for (int n = 0; n < 2; ++n) acc[a][b][m][n] = (f32x4){0.f, 0.f, 0.f, 0.f};
        cur = nxt; cA = nA; cB = nB; ++ui;
        if constexpr (ALIGN_EPI) { if (wr == 1) PG8_BAR; }
    }
    PG8_WAIT_V(0);
    if constexpr (!ALIGN_EPI) { if (wr == 0) PG8_BAR; }
    PG8_BAR;
#undef PG8_SA
#undef PG8_SB
#undef PG8_STAGE
#undef PG8_LDA
#undef PG8_LDB
#undef PG8_MMA
#undef PG8_WAIT_V
#undef PG8_WAIT_L
#undef PG8_BAR
#undef PG8_SCHED
}
}

using pg8::Unit;
struct SchedP1 {
    const char* XN; const char* W1T; int G, c;
    __device__ __forceinline__ bool next(int i, Unit& u) const {
        const int L = i * G + c; if (L >= 2048) return false;
        if (L < 1536) { pg8::tile_order(L, 64, 24, u.pm, u.pn); u.kind = (u.pn < 16) ? 0 : 1; u.A = XN + (size_t)u.pm * 256 * 1024 * 2; u.B = W1T + (size_t)u.pn * 256 * 1024 * 2; }
        else { pg8::tile_order(L - 1536, 8, 64, u.pm, u.pn); u.kind = 2; u.A = W1T + (size_t)(6144 + u.pm * 256) * 1024 * 2; u.B = XN + (size_t)u.pn * 256 * 1024 * 2; }
        return true;
    }
};
struct EpiP1 {
    static constexpr bool PERM = true;
    bf16_t* PROJ; bf16_t* GATES; bf16_t* VT; const float* bgate; unsigned* nk;
    __device__ __forceinline__ void operator()(const f32x4 (&acc)[2][2][4][2], const Unit& u, int wr, int wc, int fr, int fq) const {
        if (u.kind == 0 && u.pn >= 12) {
#pragma unroll
            for (int bj = 0; bj < 2; ++bj) { float mxv = 0.f;
#pragma unroll
                for (int ai = 0; ai < 2; ++ai)
#pragma unroll
                    for (int m = 0; m < 4; ++m) { const f32x4 a = acc[ai][bj][m][0], bq = acc[ai][bj][m][1];
                        float q = (a[0] * a[0] + a[1] * a[1]) + (a[2] * a[2] + a[3] * a[3]) + (bq[0] * bq[0] + bq[1] * bq[1]) + (bq[2] * bq[2] + bq[3] * bq[3]);
                        q += __shfl_xor(q, 16); q += __shfl_xor(q, 32); mxv = __builtin_fmaxf(mxv, q); }
                mxv = __builtin_fmaxf(mxv, __shfl_xor(mxv, 1)); mxv = __builtin_fmaxf(mxv, __shfl_xor(mxv, 2)); mxv = __builtin_fmaxf(mxv, __shfl_xor(mxv, 4)); mxv = __builtin_fmaxf(mxv, __shfl_xor(mxv, 8));
                if (fr == 0 && fq == 0) atomicMax(nk + (u.pm >= 32 ? 32 : 0) + ((u.pn - 12) * 256 + bj * 128 + wc * 32) / 32, __float_as_uint(mxv)); }
        }
        bf16_t* base; int ldc, colt; const float* bias = nullptr;
        if (u.kind == 0) { base = PROJ; ldc = PROJ_LD; colt = u.pn * 256; }
        else if (u.kind == 1) { base = GATES; ldc = 2048; colt = (u.pn - 16) * 256; bias = bgate + colt; }
        else { base = VT; ldc = MROWS; colt = u.pn * 256; }
        const int row0 = u.pm * 256 + wr * 64 + fr, col0 = colt + wc * 32 + 8 * fq;
        f32x4 bv[2][2];
#pragma unroll
        for (int bj = 0; bj < 2; ++bj)
#pragma unroll
            for (int n = 0; n < 2; ++n) bv[bj][n] = bias ? *(const f32x4*)(bias + wc * 32 + 8 * fq + bj * 128 + 4 * n) : (f32x4){0.f, 0.f, 0.f, 0.f};
#pragma unroll
        for (int ai = 0; ai < 2; ++ai)
#pragma unroll
            for (int m = 0; m < 4; ++m) { bf16_t* rowp = base + (size_t)(row0 + ai * 128 + m * 16) * ldc + col0;
#pragma unroll
                for (int bj = 0; bj < 2; ++bj) { f32x4 v0 = acc[ai][bj][m][0] + bv[bj][0], v1 = acc[ai][bj][m][1] + bv[bj][1];
                    if (u.kind == 1) {
#pragma unroll
                        for (int i = 0; i < 4; ++i) { v0[i] = fast_sigmoid(v0[i]); v1[i] = fast_sigmoid(v1[i]); } }
                    u32x4 w; w.x = cvtpk(v0[0], v0[1]); w.y = cvtpk(v0[2], v0[3]); w.z = cvtpk(v1[0], v1[1]); w.w = cvtpk(v1[2], v1[3]);
                    *(u32x4*)(rowp + bj * 128) = w; } }
    }
};
struct SchedP3 {
    const char* PROJ; const char* WBR; int G, c;
    __device__ __forceinline__ bool next(int i, Unit& u) const {
        const int L = i * G + c; if (L >= 512) return false;
        pg8::tile_order(L, 64, 8, u.pm, u.pn); u.kind = 0;
        u.A = PROJ + ((size_t)u.pm * 256 * PROJ_LD + (u.pn < 4 ? PC_SBQ : PC_DFQ)) * 2; u.B = WBR + (size_t)u.pn * 256 * 1024 * 2; return true;
    }
};
struct EpiP3 {
    static constexpr bool PERM = true;
    const bf16_t* GATES; bf16_t* Y;
    __device__ __forceinline__ void operator()(const f32x4 (&acc)[2][2][4][2], const Unit& u, int wr, int wc, int fr, int fq) const {
        const int row0 = u.pm * 256 + wr * 64 + fr, col0 = u.pn * 256 + wc * 32 + 8 * fq;
#pragma unroll
        for (int ai = 0; ai < 2; ++ai)
#pragma unroll
            for (int m = 0; m < 4; ++m) { const size_t off = (size_t)(row0 + ai * 128 + m * 16) * 2048 + col0;
#pragma unroll
                for (int bj = 0; bj < 2; ++bj) { const u32x4 g = *(const u32x4*)(GATES + off + bj * 128);
                    const f32x4 v0 = acc[ai][bj][m][0], v1 = acc[ai][bj][m][1]; u32x4 w;
                    w.x = cvtpk(v0[0] * bf2f(g.x & 0xffff), v0[1] * bf2f(g.x >> 16)); w.y = cvtpk(v0[2] * bf2f(g.y & 0xffff), v0[3] * bf2f(g.y >> 16));
                    w.z = cvtpk(v1[0] * bf2f(g.z & 0xffff), v1[1] * bf2f(g.z >> 16)); w.w = cvtpk(v1[2] * bf2f(g.w & 0xffff), v1[3] * bf2f(g.w >> 16));
                    *(u32x4*)(Y + off + bj * 128) = w; } }
    }
};
struct SchedN1024 {
    const char* A; const char* B; size_t lda_b, ldb_b; int G, c;
    __device__ __forceinline__ bool next(int i, Unit& u) const {
        const int L = i * G + c; if (L >= 256) return false;
        pg8::tile_order(L, 64, 4, u.pm, u.pn); u.kind = 0; u.A = A + (size_t)u.pm * 256 * lda_b; u.B = B + (size_t)u.pn * 256 * ldb_b; return true;
    }
};
struct EpiRes {
    static constexpr bool PERM = false;
    const float* base; float* out; bf16_t* outb; float* ss;
    __device__ __forceinline__ void operator()(const f32x4 (&acc)[2][2][4][2], const Unit& u, int wr, int wc, int fr, int fq) const {
        const int col0 = u.pn * 256 + wc * 32 + 4 * fq;
#pragma unroll
        for (int ai = 0; ai < 2; ++ai)
#pragma unroll
            for (int m = 0; m < 4; ++m) { const int row = u.pm * 256 + ai * 128 + wr * 64 + m * 16 + fr; const size_t off = (size_t)row * 1024 + col0; float q = 0.f;
#pragma unroll
                for (int bj = 0; bj < 2; ++bj)
#pragma unroll
                    for (int n = 0; n < 2; ++n) { const f32x4 o = *(const f32x4*)(base + off + bj * 128 + n * 16) + acc[ai][bj][m][n];
                        *(f32x4*)(out + off + bj * 128 + n * 16) = o; q += (o[0] * o[0] + o[1] * o[1]) + (o[2] * o[2] + o[3] * o[3]);
                        if (outb) { u32x2 w; w.x = cvtpk(o[0], o[1]); w.y = cvtpk(o[2], o[3]); *(u32x2*)(outb + off + bj * 128 + n * 16) = w; } }
                q += __shfl_xor(q, 16); q += __shfl_xor(q, 32);
                if (fq == 0) atomicAdd(ss + row, q); }
    }
};
struct SchedP5 {
    const char* A; const char* B; int G, c;
    __device__ __forceinline__ bool next(int i, Unit& u) const {
        const int L = i * G + c; if (L >= 64 * 22) return false;
        pg8::tile_order(L, 64, 22, u.pm, u.pn); u.kind = 0; u.A = A + (size_t)u.pm * 256 * 1024 * 2; u.B = B + (size_t)u.pn * 256 * 1024 * 2; return true;
    }
};
struct EpiP5 {
    static constexpr bool PERM = true;
    const float* ss; bf16_t* ACT;
    __device__ __forceinline__ void operator()(const f32x4 (&acc)[2][2][4][2], const Unit& u, int wr, int wc, int fr, int fq) const {
        const int col0 = u.pn * 128 + wc * 32 + 8 * fq;
#pragma unroll
        for (int ai = 0; ai < 2; ++ai)
#pragma unroll
            for (int m = 0; m < 4; ++m) { const int row = u.pm * 256 + ai * 128 + wr * 64 + m * 16 + fr; const float r = __builtin_amdgcn_rsqf(ss[row] * (1.0f / DM) + EPS);
                float o[8];
#pragma unroll
                for (int n = 0; n < 2; ++n)
#pragma unroll
                    for (int i = 0; i < 4; ++i) { const float g = acc[ai][0][m][n][i] * r, up = acc[ai][1][m][n][i] * r; o[4 * n + i] = g * fast_sigmoid(g) * up; }
                u32x4 w; w.x = cvtpk(o[0], o[1]); w.y = cvtpk(o[2], o[3]); w.z = cvtpk(o[4], o[5]); w.w = cvtpk(o[6], o[7]);
                *(u32x4*)(ACT + (size_t)row * DFF + col0) = w; }
    }
};

namespace att {
constexpr int KBYTES = 16384, VBYTES = 16384, TILE_BYTES = KBYTES + VBYTES;
constexpr int FLAG_OFF = 2 * TILE_BYTES;
struct TileSrc { const bf16_t* k; const bf16_t* v; unsigned vp; };

__device__ __forceinline__ void tile_dma(const TileSrc& s, LAS unsigned char* buf, int wid, int lane) {
#pragma unroll
    for (int i = 0; i < 2; ++i) {
        const int piece = wid * 2 + i;
        { const int row = piece * 4 + (lane >> 4), cc = (lane & 15) ^ (row & 15); const unsigned off = (unsigned)(row * PROJ_LD + cc * 8);
          __builtin_amdgcn_global_load_lds((const unsigned*)(s.k + off), (LAS unsigned*)(buf + piece * 1024), 16, 0, 0); }
        { const int d = piece * 8 + (lane >> 3), cc = (lane & 7) ^ ((d >> 1) & 7); const unsigned off = (unsigned)d * s.vp + (unsigned)(cc * 8);
          __builtin_amdgcn_global_load_lds((const unsigned*)(s.v + off), (LAS unsigned*)(buf + KBYTES + piece * 1024), 16, 0, 0); }
    }
}
#define ATT_DMA_WAIT() asm volatile("s_waitcnt vmcnt(0)" ::: "memory")
__device__ __forceinline__ int pi32(int r) { return (r & 0x13) | ((r & 4) << 1) | ((r & 8) >> 1); }

struct Ctx {
    const bf16_t* PROJ; bf16_t* PROJW; const bf16_t* VT; const bf16_t* METAK; const bf16_t* METAV;
    const float* subln; const float* nk; float lam;
    LAS unsigned char* lds; int tid, lane, wid, r, h;
};
__device__ __forceinline__ TileSrc tile_src(const Ctx& c, int b, int j, int kcol, int vrow) {
    TileSrc s;
    if (j >= 0) { s.k = c.PROJ + ((size_t)(b * SEQ + 64 * j)) * PROJ_LD + kcol; s.v = c.VT + (size_t)vrow * MROWS + b * SEQ + 64 * j; s.vp = MROWS; }
    else { s.k = c.METAK + kcol; s.v = c.METAV + (size_t)vrow * 64; s.vp = 64; }
    return s;
}
__device__ __forceinline__ int k_addr(int sub, int r, int chunk) { const int row = 32 * sub + pi32(r); return row * 256 + ((chunk ^ (row & 15)) << 4); }
__device__ __forceinline__ int v_addr(int d, int chunk) { return KBYTES + d * 128 + ((chunk ^ ((d >> 1) & 7)) << 4); }

__device__ __forceinline__ void sb_unit(const Ctx& c, int b, int hd, int qb) {
    int lane = c.lane; asm volatile("" : "+v"(lane));
    const int tid = c.tid, r = lane & 31, h = lane >> 5, wid = c.wid;
    const int tq = 256 * qb + 32 * wid + r;
    const size_t qrow = (size_t)(b * SEQ + tq) * PROJ_LD + PC_SBQ + hd * 128;
    bf16x8 qf[8];
#pragma unroll
    for (int ks = 0; ks < 8; ++ks) qf[ks] = *(const bf16x8*)(c.PROJ + qrow + 16 * ks + 8 * h);
    f32x16 o[4];
#pragma unroll
    for (int dt = 0; dt < 4; ++dt) o[dt] = f32x16{};
    float C = 1.0f;
    const int jmax = 4 * qb + 3, NT = jmax + 2;
    const int kcolx = PC_SBK + hd * 128, vrow = hd * 128;
    LAS unsigned* flags = (LAS unsigned*)(c.lds + FLAG_OFF);
    if (tid == 0) { flags[0] = 0u; flags[1] = 0u; flags[2] = 0u; }
    {   const TileSrc s = tile_src(c, b, jmax, kcolx, vrow); tile_dma(s, c.lds, wid, lane); }
    ATT_DMA_WAIT(); __syncthreads();
    const int mydiag = 4 * qb + (wid >> 1);
    bool finished = false;
    for (int t = 0; t < NT; ++t) {
        const int j = (t <= jmax) ? jmax - t : -1;
        const LAS unsigned char* cur = c.lds + (t & 1) * TILE_BYTES;
        const bool more = (t + 1 < NT);
        if (more) { const int jn = (t + 1 <= jmax) ? jmax - (t + 1) : -1; const TileSrc s = tile_src(c, b, jn, kcolx, vrow); tile_dma(s, c.lds + ((t + 1) & 1) * TILE_BYTES, wid, lane); }
        const bool wave_active = (j < 0) || (j <= mydiag);
        if (wave_active && !finished) {
            const int lim = (j >= 0) ? (tq - 64 * j) : NMETA;
#pragma unroll
            for (int sub = 1; sub >= 0; --sub) {
                f32x16 s = f32x16{};
#pragma unroll
                for (int ks = 0; ks < 8; ++ks) { const bf16x8 a = *(const LAS bf16x8*)(cur + k_addr(sub, r, 2 * ks + h)); s = __builtin_amdgcn_mfma_f32_32x32x16_bf16(a, qf[ks], s, 0, 0, 0); }
                float av[16], fv[16];
#pragma unroll
                for (int reg = 0; reg < 16; ++reg) {
                    const int kap = 32 * sub + 16 * (reg >> 3) + 8 * h + (reg & 7);
                    const float z = __builtin_fminf(__builtin_fmaxf(s[reg], -115.f), 115.f);
                    const float e = __builtin_amdgcn_exp2f(-z); const float beta = __builtin_amdgcn_rcpf(1.0f + e); const float f = e * beta;
                    const bool valid = kap < lim; av[reg] = valid ? beta : 0.f; fv[reg] = valid ? f : 1.f;
                }
                float run = 1.f;
#pragma unroll
                for (int reg = 15; reg >= 8; --reg) { av[reg] *= run; run *= fv[reg]; }
                const float GU = run; run = 1.f;
#pragma unroll
                for (int reg = 7; reg >= 0; --reg) { av[reg] *= run; run *= fv[reg]; }
                const float GL = run;
                const float GUo = __shfl_xor(GU, 32), GLo = __shfl_xor(GL, 32);
                const float pU = GU * GUo, pL = GL * GLo;
                const float preU = h ? C : C * GUo, preL = h ? C * pU : (C * pU) * GLo;
                C = C * (pU * pL);
                u32x4 pf0, pf1;
                pf0.x = cvtpk(av[0] * preL, av[1] * preL); pf0.y = cvtpk(av[2] * preL, av[3] * preL); pf0.z = cvtpk(av[4] * preL, av[5] * preL); pf0.w = cvtpk(av[6] * preL, av[7] * preL);
                pf1.x = cvtpk(av[8] * preU, av[9] * preU); pf1.y = cvtpk(av[10] * preU, av[11] * preU); pf1.z = cvtpk(av[12] * preU, av[13] * preU); pf1.w = cvtpk(av[14] * preU, av[15] * preU);
                const bf16x8 p0 = __builtin_bit_cast(bf16x8, pf0), p1 = __builtin_bit_cast(bf16x8, pf1);
#pragma unroll
                for (int dt = 0; dt < 4; ++dt) {
                    const bf16x8 v0 = *(const LAS bf16x8*)(cur + v_addr(32 * dt + r, 4 * sub + h));
                    const bf16x8 v1 = *(const LAS bf16x8*)(cur + v_addr(32 * dt + r, 4 * sub + 2 + h));
                    o[dt] = __builtin_amdgcn_mfma_f32_32x32x16_bf16(v0, p0, o[dt], 0, 0, 0);
                    o[dt] = __builtin_amdgcn_mfma_f32_32x32x16_bf16(v1, p1, o[dt], 0, 0, 0);
                }
            }
            finished = __all(C < 1e-20f);
        }
#if SB_EARLY_EXIT
        const int fw = t % 3;
        if (!finished && lane == 0) flags[fw] = 1u;
        ATT_DMA_WAIT(); __syncthreads();
        const unsigned any_live = flags[fw];
        if (tid == 0) flags[(fw + 2) % 3] = 0u;
        if (!any_live) break;
#else
        ATT_DMA_WAIT(); __syncthreads();
#endif
    }
    bf16_t* orow = c.PROJW + qrow;
#pragma unroll
    for (int dt = 0; dt < 4; ++dt)
#pragma unroll
        for (int g = 0; g < 4; ++g) { u32x2 w; w.x = cvtpk(o[dt][4 * g], o[dt][4 * g + 1]); w.y = cvtpk(o[dt][4 * g + 2], o[dt][4 * g + 3]); *(u32x2*)(orow + 32 * dt + 8 * g + 4 * h) = w; }
}

constexpr float DF_THR = 80.0f;
__device__ __forceinline__ float half_max(float v) { const auto rr = __builtin_amdgcn_permlane32_swap(__float_as_uint(v), __float_as_uint(v), false, false); return __builtin_fmaxf(__uint_as_float(rr[0]), __uint_as_float(rr[1])); }
__device__ __forceinline__ float half_sum(float v) { const auto rr = __builtin_amdgcn_permlane32_swap(__float_as_uint(v), __float_as_uint(v), false, false); return __uint_as_float(rr[0]) + __uint_as_float(rr[1]); }
__device__ __forceinline__ void df_unit(const Ctx& c, int b, int hd, int qb) {
    int lane = c.lane; asm volatile("" : "+v"(lane));
    const int tid = c.tid, r = lane & 31, h = lane >> 5, wid = c.wid, rg = wid & 3, cm = wid >> 2;
    const int tq = 128 * qb + 32 * rg + r;
    const size_t qrow = (size_t)(b * SEQ + tq) * PROJ_LD + PC_DFQ + hd * 128;
    bf16x8 qf[4];
#pragma unroll
    for (int ks = 0; ks < 4; ++ks) qf[ks] = *(const bf16x8*)(c.PROJ + qrow + 64 * cm + 16 * ks + 8 * h);
    float qn2 = 0.f;
#pragma unroll
    for (int ks = 0; ks < 4; ++ks)
#pragma unroll
        for (int i = 0; i < 8; ++i) { const float f = bf2f((unsigned short)qf[ks][i]); qn2 += f * f; }
    qn2 = half_sum(qn2);
    const float kmax2 = c.nk[b * 32 + hd * 4 + cm * 2] + c.nk[b * 32 + hd * 4 + cm * 2 + 1];
    const float bound0 = __builtin_sqrtf(qn2 * kmax2) * 1.02f;
    f32x16 o[4];
#pragma unroll
    for (int dt = 0; dt < 4; ++dt) o[dt] = f32x16{};
    float mref = -INFINITY, lsum = 0.f;
    const float sl2 = __builtin_amdgcn_exp2f(-(float)(hd + 1)) * LOG2E;
    const int jmax = 2 * qb + 1, NT = jmax + 2;
    const int kcolx = PC_DFK + hd * 128, vrow = 1024 + hd * 128;
    LAS unsigned* flags = (LAS unsigned*)(c.lds + FLAG_OFF);
    if (tid == 0) { flags[0] = 0u; flags[1] = 0u; flags[2] = 0u; }
    {   const TileSrc s = tile_src(c, b, jmax, kcolx, vrow); tile_dma(s, c.lds, wid, lane); }
    ATT_DMA_WAIT(); __syncthreads();
    const int mychunk = 2 * qb + (rg >> 1);
    bool finished = false;
    for (int t = 0; t < NT; ++t) {
        const int j = (t <= jmax) ? jmax - t : -1;
        const LAS unsigned char* cur = c.lds + (t & 1) * TILE_BYTES;
        const bool more = (t + 1 < NT);
        if (more) { const int jn = (t + 1 <= jmax) ? jmax - (t + 1) : -1; const TileSrc s = tile_src(c, b, jn, kcolx, vrow); tile_dma(s, c.lds + ((t + 1) & 1) * TILE_BYTES, wid, lane); }
        const bool active = (j <= mychunk);
        if (active && !finished && j < mychunk) {
            const float dmin = (float)(j >= 0 ? tq - (64 * j + 63) : tq + 1);
            finished = __all(bound0 - sl2 * dmin - mref < -DF_THR);
        }
        if (active && !finished) {
            const float tqf = (float)(j >= 0 ? tq - 64 * j : tq + NMETA);
            const bool meta = (j < 0);
            f32x16 s1 = f32x16{}, s0 = f32x16{};
#pragma unroll
            for (int ks = 0; ks < 4; ++ks) {
                const bf16x8 a1 = *(const LAS bf16x8*)(cur + k_addr(1, r, 8 * cm + 2 * ks + h));
                const bf16x8 a0 = *(const LAS bf16x8*)(cur + k_addr(0, r, 8 * cm + 2 * ks + h));
                s1 = __builtin_amdgcn_mfma_f32_32x32x16_bf16(a1, qf[ks], s1, 0, 0, 0);
                s0 = __builtin_amdgcn_mfma_f32_32x32x16_bf16(a0, qf[ks], s0, 0, 0, 0);
            }
            float mx = -INFINITY;
#pragma unroll
            for (int reg = 0; reg < 16; ++reg) {
                const int kap = 16 * (reg >> 3) + 8 * h + (reg & 7);
                float v1 = __builtin_fmaf(-sl2, __builtin_fabsf(tqf - (float)(kap + 32)), s1[reg]);
                float v0 = __builtin_fmaf(-sl2, __builtin_fabsf(tqf - (float)kap), s0[reg]);
                if (meta) { v1 = -1e30f; if (reg >= 8) v0 = -1e30f; }
                s1[reg] = v1; s0[reg] = v0; mx = __builtin_fmaxf(mx, __builtin_fmaxf(v1, v0));
            }
            mx = half_max(mx);
            if (__any(mx > mref + 8.0f)) {
                const float mnew = __builtin_fmaxf(mref, mx), sc = __builtin_amdgcn_exp2f(mref - mnew);
                lsum *= sc; mref = mnew;
#pragma unroll
                for (int dt = 0; dt < 4; ++dt) o[dt] *= sc;
            }
            float ps = 0.f;
#pragma unroll
            for (int reg = 0; reg < 16; ++reg) { const float p1 = __builtin_amdgcn_exp2f(s1[reg] - mref), p0 = __builtin_amdgcn_exp2f(s0[reg] - mref); s1[reg] = p1; s0[reg] = p0; ps += p1 + p0; }
            lsum += ps;
            u32x4 w1a, w1b, w0a, w0b;
            w1a.x = cvtpk(s1[0], s1[1]); w1a.y = cvtpk(s1[2], s1[3]); w1a.z = cvtpk(s1[4], s1[5]); w1a.w = cvtpk(s1[6], s1[7]);
            w1b.x = cvtpk(s1[8], s1[9]); w1b.y = cvtpk(s1[10], s1[11]); w1b.z = cvtpk(s1[12], s1[13]); w1b.w = cvtpk(s1[14], s1[15]);
            w0a.x = cvtpk(s0[0], s0[1]); w0a.y = cvtpk(s0[2], s0[3]); w0a.z = cvtpk(s0[4], s0[5]); w0a.w = cvtpk(s0[6], s0[7]);
            w0b.x = cvtpk(s0[8], s0[9]); w0b.y = cvtpk(s0[10], s0[11]); w0b.z = cvtpk(s0[12], s0[13]); w0b.w = cvtpk(s0[14], s0[15]);
            const bf16x8 p1a = __builtin_bit_cast(bf16x8, w1a), p1b = __builtin_bit_cast(bf16x8, w1b), p0a = __builtin_bit_cast(bf16x8, w0a), p0b = __builtin_bit_cast(bf16x8, w0b);
#pragma unroll
            for (int dt = 0; dt < 4; ++dt) {
                const bf16x8 v1a = *(const LAS bf16x8*)(cur + v_addr(32 * dt + r, 4 + h));
                const bf16x8 v1b = *(const LAS bf16x8*)(cur + v_addr(32 * dt + r, 6 + h));
                const bf16x8 v0a = *(const LAS bf16x8*)(cur + v_addr(32 * dt + r, 0 + h));
                const bf16x8 v0b = *(const LAS bf16x8*)(cur + v_addr(32 * dt + r, 2 + h));
                o[dt] = __builtin_amdgcn_mfma_f32_32x32x16_bf16(v1a, p1a, o[dt], 0, 0, 0);
                o[dt] = __builtin_amdgcn_mfma_f32_32x32x16_bf16(v1b, p1b, o[dt], 0, 0, 0);
                o[dt] = __builtin_amdgcn_mfma_f32_32x32x16_bf16(v0a, p0a, o[dt], 0, 0, 0);
                o[dt] = __builtin_amdgcn_mfma_f32_32x32x16_bf16(v0b, p0b, o[dt], 0, 0, 0);
            }
        }
        const int fw = t % 3;
        if (!finished && lane == 0) flags[fw] = 1u;
        ATT_DMA_WAIT(); __syncthreads();
        const unsigned any_live = flags[fw];
        if (tid == 0) flags[(fw + 2) % 3] = 0u;
        if (!any_live) break;
    }
    const float L = half_sum(lsum);
    const float inv = (cm == 0 ? 1.0f : c.lam) / L;
    LAS float* xch = (LAS float*)(c.lds + rg * 16384);
    if (cm == 1) {
#pragma unroll
        for (int dt = 0; dt < 4; ++dt)
#pragma unroll
            for (int reg = 0; reg < 16; ++reg) xch[(dt * 16 + reg) * 64 + lane] = o[dt][reg] * inv;
    }
    __syncthreads();
    if (cm == 0) {
        float ss = 0.f;
#pragma unroll
        for (int dt = 0; dt < 4; ++dt)
#pragma unroll
            for (int reg = 0; reg < 16; ++reg) { const float v = o[dt][reg] * inv - xch[(dt * 16 + reg) * 64 + lane]; o[dt][reg] = v; ss += v * v; }
        ss = half_sum(ss);
        const float rs = __builtin_amdgcn_rsqf(ss * (1.0f / 128.0f) + EPS) * 0.8f;
        bf16_t* orow = c.PROJW + qrow;
#pragma unroll
        for (int dt = 0; dt < 4; ++dt)
#pragma unroll
            for (int g = 0; g < 4; ++g) { const int d0 = 32 * dt + 8 * g + 4 * h; const f32x4 gn = *(const f32x4*)(c.subln + d0);
                u32x2 w; w.x = cvtpk(o[dt][4 * g] * rs * gn[0], o[dt][4 * g + 1] * rs * gn[1]); w.y = cvtpk(o[dt][4 * g + 2] * rs * gn[2], o[dt][4 * g + 3] * rs * gn[3]);
                *(u32x2*)(orow + d0) = w; }
    }
    __syncthreads();
}
}


#define XB_TMO      128
#define XB_XCNT(j)  (256  + 64 * (j))
#define XB_XSUB(j)  (1280 + 64 * (j))
#define XB_XGEN(j)  (2304 + 64 * (j))
#define XB_TOP      3328
#define XB_TOPGEN   3392
#define XCD_BAR_WORDS 3456
#define XB_SPIN_CAP (1u << 22)
__device__ __forceinline__ unsigned xb_ld(unsigned* p)              { return __hip_atomic_load(p, __ATOMIC_RELAXED, __HIP_MEMORY_SCOPE_AGENT); }
__device__ __forceinline__ unsigned xb_add(unsigned* p, unsigned v) { return __hip_atomic_fetch_add(p, v, __ATOMIC_RELAXED, __HIP_MEMORY_SCOPE_AGENT); }
__device__ __forceinline__ unsigned xb_xcc_id() { return (unsigned)__builtin_amdgcn_s_getreg((3 << 11) | 20) & 0xFu; }
#define XB_SPIN(cond, bar) do { unsigned _sp = 0; while (cond) { __builtin_amdgcn_s_sleep(1); \
    if ((++_sp & 255u) == 0u) { if (xb_ld(&(bar)[XB_TMO])) break; if (_sp > XB_SPIN_CAP) { atomicAdd(&(bar)[XB_TMO], 1u); break; } } } } while (0)
struct XcdBarrier { unsigned* bar; unsigned x; volatile LAS unsigned* st; };
__device__ __forceinline__ XcdBarrier xcd_barrier_post(unsigned* bar, volatile LAS unsigned* st) {
    XcdBarrier b; b.bar = bar; b.x = xb_xcc_id(); b.st = st;
    if (threadIdx.x == 0) (void)xb_add(&bar[XB_XCNT(b.x)], 1u);
    return b;
}
__device__ __forceinline__ void xcd_barrier_complete(unsigned* bar, unsigned x, unsigned& nloc, unsigned& nx) {
    const unsigned G = gridDim.x * gridDim.y * gridDim.z;
    unsigned sum, cnt, mine, sp = 0u;
    for (;;) {
        sum = 0u; cnt = 0u; mine = 0u;
#pragma unroll
        for (unsigned j = 0; j < 16; ++j) { const unsigned c = xb_ld(&bar[XB_XCNT(j)]); sum += c; cnt += (c > 0u) ? 1u : 0u; mine = (j == x) ? c : mine; }
        if (sum == G) break;
        __builtin_amdgcn_s_sleep(1);
        if ((++sp & 255u) == 0u) { if (xb_ld(&bar[XB_TMO])) break; if (sp > XB_SPIN_CAP) { atomicAdd(&bar[XB_TMO], 1u); break; } }
    }
    nloc = mine > 0u ? mine : 1u; nx = cnt > 0u ? cnt : 1u;
}
__device__ __forceinline__ void xcd_barrier(const XcdBarrier& b) {
    asm volatile("s_waitcnt vmcnt(0)" ::: "memory");
    __syncthreads();
    if (threadIdx.x == 0) {
        unsigned* bar = b.bar;
        __builtin_amdgcn_s_waitcnt(0);
        unsigned nloc = b.st[0], nx = b.st[1];
        if (nloc == 0u) { xcd_barrier_complete(bar, b.x, nloc, nx); b.st[0] = nloc; b.st[1] = nx; }
        const unsigned old = xb_add(&bar[XB_XSUB(b.x)], 1u);
        const unsigned gen = old / nloc;
        if (old + 1u == (gen + 1u) * nloc) {
            __builtin_amdgcn_fence(__ATOMIC_RELEASE, "agent");
            asm volatile("s_waitcnt vmcnt(0)" ::: "memory");
            const unsigned og = xb_add(&bar[XB_TOP], 1u);
            const unsigned tg = og / nx;
            if (og + 1u == (tg + 1u) * nx) xb_add(&bar[XB_TOPGEN], 1u);
            else XB_SPIN(xb_ld(&bar[XB_TOPGEN]) == tg, bar);
            __builtin_amdgcn_fence(__ATOMIC_ACQUIRE, "agent");
            xb_add(&bar[XB_XGEN(b.x)], 1u);
            asm volatile("s_waitcnt vmcnt(0)" ::: "memory");
        } else {
            XB_SPIN(xb_ld(&bar[XB_XGEN(b.x)]) == gen, bar);
            __builtin_amdgcn_fence(__ATOMIC_ACQUIRE, "agent");
            asm volatile("s_waitcnt vmcnt(0)" ::: "memory");
        }
    }
    __syncthreads();
}

__device__ __forceinline__ void transpose_item(const float* W, int ldw, int k0, int n0, bf16_t* WT, int ldwt, int drow0, int dcol0, int dup_off, float scale, const float* kscale, LAS float* scr, int lane) {
#pragma unroll 8
    for (int i = 0; i < 32; ++i) { const int kk = 2 * i + (lane >> 5); float v = W[(size_t)(k0 + kk) * ldw + n0 + (lane & 31)] * scale; if (kscale) v *= kscale[k0 + kk]; scr[kk * 33 + (lane & 31)] = v; }
    asm volatile("s_waitcnt lgkmcnt(0)" ::: "memory");
    const int cc = lane & 7;
#pragma unroll
    for (int jj = 0; jj < 4; ++jj) { const int n = (lane >> 3) + 8 * jj; const LAS float* s = scr + (8 * cc) * 33 + n;
        u32x4 ov; ov.x = cvtpk(s[0 * 33], s[1 * 33]); ov.y = cvtpk(s[2 * 33], s[3 * 33]); ov.z = cvtpk(s[4 * 33], s[5 * 33]); ov.w = cvtpk(s[6 * 33], s[7 * 33]);
        bf16_t* dst = WT + (size_t)(drow0 + n) * ldwt + dcol0 + k0 + 8 * cc;
        *(u32x4*)dst = ov; if (dup_off) *(u32x4*)(dst + dup_off) = ov; }
    asm volatile("s_waitcnt lgkmcnt(0)" ::: "memory");
}

constexpr int LDS_BYTES = 147456, LDS_MISC_OFF = LDS_BYTES - 64;
struct Args { const float* in[19]; float* out; unsigned char* ws; int ph_lo, ph_hi; };

__global__ void __launch_bounds__(NTHREADS, 2) fwd_kernel(Args args) {
    extern __shared__ __attribute__((aligned(16))) unsigned char lds_raw[];
    LAS unsigned char* lds = (LAS unsigned char*)lds_raw;
    const int tid = threadIdx.x, lane = tid & 63, wid = __builtin_amdgcn_readfirstlane(tid >> 6);
    const int G = gridDim.x, bx = blockIdx.x;
    unsigned char* ws = args.ws;
    const float* x = args.in[0];
    bf16_t* W1T = (bf16_t*)(ws + WS_W1T); bf16_t* XN = (bf16_t*)(ws + WS_XN); bf16_t* PROJ = (bf16_t*)(ws + WS_PROJ); bf16_t* GATES = (bf16_t*)(ws + WS_GATES);
    bf16_t* METAK = (bf16_t*)(ws + WS_METAK); bf16_t* METAV = (bf16_t*)(ws + WS_METAV);
    bf16_t* WBR = (bf16_t*)(ws + WS_WBR); bf16_t* WOUT2 = (bf16_t*)(ws + WS_WOUT2); bf16_t* WFFN = (bf16_t*)(ws + WS_WFFN); bf16_t* WDOWN = (bf16_t*)(ws + WS_WDOWN);
    bf16_t* H1B = (bf16_t*)(ws + WS_H1B); bf16_t* ACT = (bf16_t*)(ws + WS_ACT); float* H1 = (float*)(ws + WS_H1);
    float* SS1 = (float*)(ws + CTL_SS1); float* SS2 = (float*)(ws + CTL_SS2);
    bf16_t* VT = (bf16_t*)args.out; bf16_t* Y = (bf16_t*)args.out;
    const int gw = bx * NWAVES + wid, NGW = G * NWAVES;
    const int lo = args.ph_lo, hi = args.ph_hi;
#define IN(k) (lo <= (k) && (k) < hi)
#if MK_N_LAUNCHES == 1
    volatile LAS unsigned* bar_st = (volatile LAS unsigned*)(lds + LDS_MISC_OFF);
    if (tid < 2) bar_st[tid] = 0u;
    __syncthreads();
    const XcdBarrier gbar = xcd_barrier_post((unsigned*)(ws + CTL_BAR), bar_st);
    if (args.ph_lo < 0) cg::this_grid().sync();
#define GRID_BAR() xcd_barrier(gbar)
#else
#define GRID_BAR() do {} while (0)
#endif

    if (IN(0)) {
        LAS float* scr = (LAS float*)(lds + wid * 16384);
        const float* w_in = args.in[3]; const float* w_gate = args.in[4];
        const float cq_sb = LOG2E * 0.08838834764831845f, cq_df = LOG2E * 0.125f;
        for (int it = gw; it < 16 * 256; it += NGW) {
            const int kb = it >> 8, nb = it & 255, blk = nb >> 5, nin = (nb & 31) * 32;
            const float* src; int ldw, n0; float sc = 1.f;
            switch (blk) {
                case 0: src = w_in; ldw = 6144; n0 = 0 + nin; sc = cq_sb; break;
                case 1: src = w_in; ldw = 6144; n0 = 1024 + nin; break;
                case 2: src = w_in; ldw = 6144; n0 = 3072 + nin; sc = cq_df; break;
                case 3: src = w_in; ldw = 6144; n0 = 4096 + nin; break;
                case 4: src = w_gate; ldw = 2048; n0 = nin; break;
                case 5: src = w_gate; ldw = 2048; n0 = 1024 + nin; break;
                case 6: src = w_in; ldw = 6144; n0 = 2048 + nin; break;
                default: src = w_in; ldw = 6144; n0 = 5120 + nin; break;
            }
            transpose_item(src, ldw, kb * 64, n0, W1T, 1024, nb * 32, 0, 0, sc, nullptr, scr, lane);
        }
        {   const float* g = args.in[2];
            f32x4 gv[4];
#pragma unroll
            for (int jj = 0; jj < 4; ++jj) gv[jj] = *((const f32x4*)g + lane + 64 * jj);
            for (int m = gw; m < MROWS; m += NGW) {
                const f32x4* xr = (const f32x4*)(x + (size_t)m * DM) + lane; f32x4 v[4]; float s = 0.f;
#pragma unroll
                for (int jj = 0; jj < 4; ++jj) { v[jj] = xr[64 * jj]; s += (v[jj].x * v[jj].x + v[jj].y * v[jj].y) + (v[jj].z * v[jj].z + v[jj].w * v[jj].w); }
                const float rstd = __builtin_amdgcn_rsqf(wave_sum(s) * (1.0f / DM) + EPS);
                u32x2* o8 = (u32x2*)(XN + (size_t)m * DM) + lane;
#pragma unroll
                for (int jj = 0; jj < 4; ++jj) { u32x2 w; w.x = cvtpk(v[jj].x * rstd * gv[jj].x, v[jj].y * rstd * gv[jj].y); w.y = cvtpk(v[jj].z * rstd * gv[jj].z, v[jj].w * rstd * gv[jj].w); o8[64 * jj] = w; }
            }
        }
        if (bx < 32) {
            __syncthreads();
            LAS float* xm = (LAS float*)lds;
            LAS float* part = (LAS float*)(lds + 65536);
            const float* meta = args.in[1]; const float* g = args.in[2];
            for (int rr = 0; rr < 2; ++rr) { const int row = 2 * wid + rr; const f32x4* xr = (const f32x4*)(meta + (size_t)row * DM) + lane; f32x4 v[4]; float s = 0.f;
#pragma unroll
                for (int jj = 0; jj < 4; ++jj) { v[jj] = xr[64 * jj]; s += (v[jj].x * v[jj].x + v[jj].y * v[jj].y) + (v[jj].z * v[jj].z + v[jj].w * v[jj].w); }
                const float rstd = __builtin_amdgcn_rsqf(wave_sum(s) * (1.0f / DM) + EPS);
#pragma unroll
                for (int jj = 0; jj < 4; ++jj) { const f32x4 gg = *((const f32x4*)g + lane + 64 * jj); f32x4 w = v[jj] * rstd * gg; *(LAS f32x4*)(xm + row * 1024 + 4 * (lane + 64 * jj)) = w; } }
            __syncthreads();
            const int cl = tid & 127, kq = tid >> 7, blk = bx >> 3, col = (bx & 7) * 128 + cl;
            const int srcc = (blk == 0 ? 1024 : blk == 1 ? 2048 : blk == 2 ? 4096 : 5120) + col;
            float acc[16];
#pragma unroll
            for (int i = 0; i < 16; ++i) acc[i] = 0.f;
            for (int k = kq * 256; k < kq * 256 + 256; ++k) { const float w = w_in[(size_t)k * 6144 + srcc];
#pragma unroll
                for (int i = 0; i < 16; ++i) acc[i] = __builtin_fmaf(xm[i * 1024 + k], w, acc[i]); }
#pragma unroll
            for (int i = 0; i < 16; ++i) part[(kq * 16 + i) * 128 + cl] = acc[i];
            __syncthreads();
            if (blk == 0 || blk == 2) {
                const int row = tid >> 5, c4 = (tid & 31) * 4; float v[4];
#pragma unroll
                for (int i = 0; i < 4; ++i) v[i] = (part[(0 * 16 + row) * 128 + c4 + i] + part[(1 * 16 + row) * 128 + c4 + i]) + (part[(2 * 16 + row) * 128 + c4 + i] + part[(3 * 16 + row) * 128 + c4 + i]);
                if (blk == 2) { float q = (v[0] * v[0] + v[1] * v[1]) + (v[2] * v[2] + v[3] * v[3]); q += __shfl_xor(q, 1); q += __shfl_xor(q, 2); q += __shfl_xor(q, 4);
                    if ((tid & 7) == 0) { unsigned* nk = (unsigned*)(ws + CTL_NK); const int id = ((bx & 7) * 128 + c4) / 32; atomicMax(nk + id, __float_as_uint(q)); atomicMax(nk + 32 + id, __float_as_uint(q)); } }
                const int dcol = (blk == 2 ? PC_DFK : PC_SBK) + (bx & 7) * 128 + c4;
                u32x2 w; w.x = cvtpk(v[0], v[1]); w.y = cvtpk(v[2], v[3]); *(u32x2*)(METAK + (size_t)row * PROJ_LD + dcol) = w;
                const u32x2 z = {0u, 0u};
#pragma unroll
                for (int i = 0; i < 3; ++i) *(u32x2*)(METAK + (size_t)(16 + row + 16 * i) * PROJ_LD + dcol) = z;
            } else if (tid < 128) {
                float v[16];
#pragma unroll
                for (int i = 0; i < 16; ++i) v[i] = (part[(0 * 16 + i) * 128 + cl] + part[(1 * 16 + i) * 128 + cl]) + (part[(2 * 16 + i) * 128 + cl] + part[(3 * 16 + i) * 128 + cl]);
                bf16_t* dst = METAV + (size_t)((blk == 3 ? 1024 : 0) + col) * 64;
                u32x4 w0, w1; const u32x4 z = {0u, 0u, 0u, 0u};
                w0.x = cvtpk(v[0], v[1]); w0.y = cvtpk(v[2], v[3]); w0.z = cvtpk(v[4], v[5]); w0.w = cvtpk(v[6], v[7]);
                w1.x = cvtpk(v[8], v[9]); w1.y = cvtpk(v[10], v[11]); w1.z = cvtpk(v[12], v[13]); w1.w = cvtpk(v[14], v[15]);
                *(u32x4*)(dst) = w0; *(u32x4*)(dst + 8) = w1;
#pragma unroll
                for (int i = 2; i < 8; ++i) *(u32x4*)(dst + 8 * i) = z;
            }
        }
        if (IN(1)) GRID_BAR();
    }

    if (IN(1)) {
        SchedP1 S{(const char*)XN, (const char*)W1T, G, bx};
        EpiP1 E{PROJ, GATES, VT, args.in[5], (unsigned*)(ws + CTL_NK)};
        pg8::gemm_phase<EpiP1, SchedP1, true>(lds, 1024, 1024, 1024, S, E);
        if (IN(2)) GRID_BAR();
    }

    if (IN(2)) {
        {   LAS float* scr = (LAS float*)(lds + wid * 16384);
            const float* w_br_sb = args.in[11]; const float* w_br_df = args.in[12]; const float* w_out = args.in[13]; const float* gffn = args.in[14];
            const float* w_fg = args.in[15]; const float* w_fu = args.in[16]; const float* w_fd = args.in[17];
            constexpr int I_BR = 16 * 32, I_FFN = 16 * 176, I_DN = 44 * 32, I_ALL = 3 * I_BR + I_FFN + I_DN;
            for (int it0 = gw; it0 < I_ALL; it0 += NGW) {
                int it = it0;
                if (it < I_BR) { transpose_item(w_br_sb, 1024, (it >> 5) * 64, (it & 31) * 32, WBR, 1024, (it & 31) * 32, 0, 0, 1.f, nullptr, scr, lane); continue; } it -= I_BR;
                if (it < I_BR) { transpose_item(w_br_df, 1024, (it >> 5) * 64, (it & 31) * 32, WBR, 1024, 1024 + (it & 31) * 32, 0, 0, 1.f, nullptr, scr, lane); continue; } it -= I_BR;
                if (it < I_BR) { transpose_item(w_out, 1024, (it >> 5) * 64, (it & 31) * 32, WOUT2, 2048, (it & 31) * 32, 0, 1024, 1.f, nullptr, scr, lane); continue; } it -= I_BR;
                if (it < I_FFN) { const int kb = it / 176, nb = it % 176, R = nb * 32, p = R >> 8, rr = R & 255;
                    const float* src = (rr < 128) ? w_fg : w_fu; const int n0 = 128 * p + (rr & 127);
                    transpose_item(src, DFF, kb * 64, n0, WFFN, 1024, R, 0, 0, 1.f, gffn, scr, lane); continue; } it -= I_FFN;
                transpose_item(w_fd, 1024, (it >> 5) * 64, (it & 31) * 32, WDOWN, DFF, (it & 31) * 32, 0, 0, 1.f, nullptr, scr, lane);
            }
        }
        __syncthreads();
        att::Ctx c; c.PROJ = PROJ; c.PROJW = PROJ; c.VT = VT; c.METAK = METAK; c.METAV = METAV; c.subln = args.in[10]; c.nk = (const float*)(ws + CTL_NK); c.lds = lds; c.tid = tid; c.lane = lane; c.wid = wid; c.r = lane & 31; c.h = lane >> 5;
        {   const float a1 = args.in[6][lane] * args.in[7][lane], a2 = args.in[8][lane] * args.in[9][lane];
            c.lam = __expf(wave_sum(a1)) - __expf(wave_sum(a2)) + 0.2f; }
        LAS unsigned* flags = (LAS unsigned*)(lds + att::FLAG_OFF);
        if (tid < 8) flags[tid] = 0u;
        __syncthreads();
        unsigned* queue = (unsigned*)(ws + CTL_QUEUE);
        for (;;) {
            if (tid == 0) flags[4] = atomicAdd(queue, 1u);
            __syncthreads();
            const unsigned u = flags[4];
            __syncthreads();
            if (u >= 1536u) break;
            if (u < 1024u) {
#ifndef NO_DF
                const int qb = 63 - (int)(u >> 4), hb = (int)(u & 15), hd = 7 - (hb >> 1), b = hb & 1; att::df_unit(c, b, hd, qb);
#endif
            }
            else {
#ifndef NO_SB
                const unsigned v = u - 1024u; const int qb = 31 - (int)(v >> 4), hb = (int)(v & 15), hd = hb >> 1, b = hb & 1; att::sb_unit(c, b, hd, qb);
#endif
            }
        }
        if (IN(3)) GRID_BAR();
    }

    if (IN(3)) {
        SchedP3 S{(const char*)PROJ, (const char*)WBR, G, bx};
        EpiP3 E{GATES, Y};
        pg8::gemm_phase<EpiP3, SchedP3, true>(lds, 1024, PROJ_LD, 1024, S, E);
        if (IN(4)) GRID_BAR();
    }

    if (IN(4)) {
        SchedN1024 S{(const char*)Y, (const char*)WOUT2, (size_t)2048 * 2, (size_t)2048 * 2, G, bx};
        EpiRes E{x, H1, H1B, SS1};
        pg8::gemm_phase<EpiRes, SchedN1024, false>(lds, 2048, 2048, 2048, S, E);
        if (IN(5)) GRID_BAR();
    }

    if (IN(5)) {
        SchedP5 S{(const char*)H1B, (const char*)WFFN, G, bx};
        EpiP5 E{SS1, ACT};
        pg8::gemm_phase<EpiP5, SchedP5, true>(lds, 1024, 1024, 1024, S, E);
        if (IN(6)) GRID_BAR();
    }

    if (IN(6)) {
        SchedN1024 S{(const char*)ACT, (const char*)WDOWN, (size_t)DFF * 2, (size_t)DFF * 2, G, bx};
        EpiRes E{H1, args.out, nullptr, SS2};
        pg8::gemm_phase<EpiRes, SchedN1024, false>(lds, DFF, DFF, DFF, S, E);
        if (IN(7)) GRID_BAR();
    }

    if (IN(7)) {
        const float* g = args.in[18];
        f32x4 gv[4];
#pragma unroll
        for (int jj = 0; jj < 4; ++jj) gv[jj] = *((const f32x4*)g + lane + 64 * jj);
        for (int m = gw; m < MROWS; m += NGW) {
            f32x4* xr = (f32x4*)(args.out + (size_t)m * DM) + lane; const float rstd = __builtin_amdgcn_rsqf(SS2[m] * (1.0f / DM) + EPS);
#pragma unroll
            for (int jj = 0; jj < 4; ++jj) { f32x4 v = xr[64 * jj]; v = v * rstd * gv[jj]; xr[64 * jj] = v; }
        }
    }
#undef IN
}

extern "C" void kernel_launch(void* const* d_in, const int* in_sizes, int n_in, void* d_out, int out_size, void* d_ws, size_t ws_size, hipStream_t stream) {
    static int grid = 0;
    if (grid == 0) {
        if (n_in != 19 || out_size != MROWS * DM || ws_size < WS_END) { fprintf(stderr, "kernel_launch: unexpected shapes (n_in %d out %d ws %zu)\n", n_in, out_size, ws_size); grid = -1; return; }
        int dev = 0, cus = 0, per_cu = 0;
        hipGetDevice(&dev); hipDeviceGetAttribute(&cus, hipDeviceAttributeMultiprocessorCount, dev);
        if (hipFuncSetAttribute((const void*)fwd_kernel, hipFuncAttributeMaxDynamicSharedMemorySize, LDS_BYTES) != hipSuccess) { fprintf(stderr, "kernel_launch: hipFuncSetAttribute failed\n"); grid = -1; return; }
        if (hipOccupancyMaxActiveBlocksPerMultiprocessor(&per_cu, (const void*)fwd_kernel, NTHREADS, LDS_BYTES) != hipSuccess || per_cu < 1) { fprintf(stderr, "kernel_launch: occupancy query says %d\n", per_cu); per_cu = 1; }
        (void)hipGetLastError();
        grid = cus * 1;
    }
    if (grid < 0) return;
    (void)hipMemsetAsync((char*)d_ws + WS_CTL, 0, CTL_BYTES, stream);
    Args a{};
    for (int i = 0; i < 19; ++i) a.in[i] = (const float*)d_in[i];
    a.out = (float*)d_out; a.ws = (unsigned char*)d_ws;
#if MK_N_LAUNCHES == 1
    a.ph_lo = 0; a.ph_hi = 8;
    void* kargs[] = {&a};
    hipError_t e = hipLaunchCooperativeKernel((const void*)fwd_kernel, dim3(grid), dim3(NTHREADS), kargs, LDS_BYTES, stream);
    if (e != hipSuccess) fprintf(stderr, "kernel_launch: cooperative launch failed: %s (grid %d)\n", hipGetErrorString(e), grid);
#else
    for (int p = 0; p < 8; ++p) { a.ph_lo = p; a.ph_hi = p + 1; hipLaunchKernelGGL(fwd_kernel, dim3(grid), dim3(NTHREADS), LDS_BYTES, stream, a); }
#endif
}
```

```cpp
#include <hip/hip_runtime.h>
#include <hip/hip_cooperative_groups.h>
#include <cstdio>
#include <cstdint>
namespace cg = cooperative_groups;

#ifndef MK_N_LAUNCHES
#define MK_N_LAUNCHES 1
#endif
#ifndef SB_EARLY_EXIT
#define SB_EARLY_EXIT 1
#endif

#define LAS __attribute__((address_space(3)))
typedef unsigned short bf16_t;
typedef short bf16x8 __attribute__((ext_vector_type(8)));
typedef float f32x4 __attribute__((ext_vector_type(4)));
typedef float f32x16 __attribute__((ext_vector_type(16)));
typedef unsigned u32x4 __attribute__((ext_vector_type(4)));
typedef unsigned u32x2 __attribute__((ext_vector_type(2)));
typedef float f32x2_t __attribute__((ext_vector_type(2)));
typedef __bf16 bf16x2_t __attribute__((ext_vector_type(2)));

constexpr int SEQ = 8192, DM = 1024, MROWS = 2 * SEQ, NMETA = 16, DFF = 2816;
constexpr float EPS = 1e-6f;
constexpr float LOG2E = 1.4426950408889634f;
constexpr int NWAVES = 8, NTHREADS = 512;
constexpr int PROJ_LD = 4096 + 128;
constexpr int PC_SBQ = 0, PC_SBK = 1024, PC_DFQ = 2048, PC_DFK = 3072;

constexpr size_t MiB = 1u << 20;
constexpr size_t WS_CTL = 0, CTL_BYTES = 224 * 1024;
constexpr size_t CTL_QUEUE = 256;
constexpr size_t CTL_NK = 1024;
constexpr size_t CTL_PCNT = 4096;
constexpr size_t CTL_BAR = 64 * 1024;
constexpr size_t CTL_SS1 = 96 * 1024, CTL_SS2 = 160 * 1024;
constexpr size_t WS_W1T = 1 * MiB;
constexpr size_t WS_METAK = 17 * MiB;
constexpr size_t WS_METAV = WS_METAK + 640 * 1024;
constexpr size_t WS_XN = 18 * MiB;
constexpr size_t WS_WBR = 18 * MiB;
constexpr size_t WS_WOUT2 = 22 * MiB;
constexpr size_t WS_WFFN = 26 * MiB;
constexpr size_t WS_WDOWN = 38 * MiB;
constexpr size_t WS_PROJ = 50 * MiB;
constexpr size_t WS_H1B = 50 * MiB;
constexpr size_t WS_ACT = 82 * MiB;
constexpr size_t WS_GATES = 184 * MiB;
constexpr size_t WS_H1 = 184 * MiB;
constexpr size_t WS_END = 248 * MiB;

__device__ __forceinline__ unsigned cvtpk(float lo, float hi) { f32x2_t v = {lo, hi}; bf16x2_t b = __builtin_convertvector(v, bf16x2_t); return __builtin_bit_cast(unsigned, b); }
__device__ __forceinline__ float bf2f(unsigned short b) { return __builtin_bit_cast(float, (unsigned)b << 16); }
__device__ __forceinline__ float wave_sum(float v) {
#pragma unroll
    for (int o = 1; o < 64; o <<= 1) v += __shfl_xor(v, o);
    return v;
}
__device__ __forceinline__ void st16_wt(void* p, u32x4 v) { asm volatile("global_store_dwordx4 %0, %1, off sc1\n\ts_nop 1" :: "v"(p), "v"(v) : "memory"); }
__device__ __forceinline__ float fast_sigmoid(float x) { return __builtin_amdgcn_rcpf(1.0f + __builtin_amdgcn_exp2f(-x * LOG2E)); }

namespace pg8 {
constexpr int BM = 256, BK = 64, HALF = 128, HTB = HALF * BK * 2, STAGE_BYTES = 8 * HTB, NXCD = 8;
__host__ __device__ __forceinline__ int lds_byte(int r, int c) { const int st = (r >> 4) * 2 + (c >> 5), rr = r & 15, cc = c & 31, ob = rr * 64 + cc * 2; return st * 1024 + (ob ^ (((ob >> 9) & 1) << 5)); }
__host__ __device__ __forceinline__ void stage_rc(int b, int& R, int& C) { const int st = b / 1024, sb = b % 1024, swz = sb ^ (((sb >> 9) & 1) << 5); R = (st >> 1) * 16 + swz / 64; C = (st & 1) * 32 + (swz % 64) / 2; }
__host__ __device__ __forceinline__ int perm32(int rho) { const int n = rho >> 4, i = rho & 15; return 8 * (i >> 2) + 4 * n + (i & 3); }

struct Unit { int pm, pn, kind; const char* A; const char* B; };
__device__ __forceinline__ void tile_order(int wgid, int nM, int nN, int& pm, int& pn, const int WGM = 2) {
    const int nwg = nM * nN;
    { const int q = nwg / NXCD, r = nwg % NXCD, xcd = wgid % NXCD, off = wgid / NXCD; wgid = (xcd < r ? xcd * (q + 1) : r * (q + 1) + (xcd - r) * q) + off; }
    const int nig = WGM * nN, gid = wgid / nig, fm = gid * WGM, gsz = (nM - fm) < WGM ? (nM - fm) : WGM;
    pm = fm + ((wgid % nig) % gsz); pn = (wgid % nig) / gsz;
}
template <class Epi, class Sched, bool ALIGN_EPI>
__device__ __forceinline__ void gemm_phase(LAS unsigned char* lds, const int K, const int lda, const int ldb, const Sched& S, const Epi& E) {
    const int tid = threadIdx.x, wid = __builtin_amdgcn_readfirstlane(tid >> 6), lane = tid & 63, wr = wid >> 2, wc = wid & 3, fr = lane & 15, fq = lane >> 4;
    const int nt = K / BK;
    unsigned voffA[2], voffB[2];
#pragma unroll
    for (int i = 0; i < 2; ++i) { int R, C; stage_rc(tid * 16 + i * 8192, R, C); const int Rb = Epi::PERM ? ((R & ~31) + perm32(R & 31)) : R;
        voffA[i] = (unsigned)(R * lda + C) * 2u; voffB[i] = (unsigned)(Rb * ldb + C) * 2u; }
    const size_t kstep = (size_t)(BK * 2);
    const size_t hstepA = (size_t)HALF * lda * 2, hstepB = (size_t)HALF * ldb * 2;
    const unsigned ldsw = (unsigned)wid * 1024u;
    const int aoff = lds_byte(wr * 64 + fr, fq * 8), boff = lds_byte(wc * 32 + fr, fq * 8);
#define PG8_SA(b, h) (((b) * 2 + (h)) * HTB)
#define PG8_SB(b, h) ((4 + (b) * 2 + (h)) * HTB)
#define PG8_STAGE(bufoff, gbase, voff) do { _Pragma("unroll") for (int _i = 0; _i < 2; ++_i) \
        __builtin_amdgcn_global_load_lds((const unsigned*)((const char*)(gbase) + (voff)[_i]), (LAS unsigned*)(lds + (bufoff) + ldsw + _i * 8192), 16, 0, 0); } while (0)
#define PG8_LDA(dst, b, h) do { _Pragma("unroll") for (int m = 0; m < 4; ++m) _Pragma("unroll") for (int k = 0; k < 2; ++k) dst[m][k] = *(const LAS bf16x8*)(lds + PG8_SA(b, h) + aoff + m * 2048 + k * 1024); } while (0)
#define PG8_LDB(dst, b, h) do { _Pragma("unroll") for (int n = 0; n < 2; ++n) _Pragma("unroll") for (int k = 0; k < 2; ++k) dst[n][k] = *(const LAS bf16x8*)(lds + PG8_SB(b, h) + boff + n * 2048 + k * 1024); } while (0)
#define PG8_MMA(ai, bj, At, Bt) do { __builtin_amdgcn_s_setprio(1); _Pragma("unroll") for (int m = 0; m < 4; ++m) _Pragma("unroll") for (int n = 0; n < 2; ++n) _Pragma("unroll") for (int k = 0; k < 2; ++k) \
        acc[ai][bj][m][n] = __builtin_amdgcn_mfma_f32_16x16x32_bf16(Bt[n][k], At[m][k], acc[ai][bj][m][n], 0, 0, 0); __builtin_amdgcn_s_setprio(0); } while (0)
#define PG8_WAIT_V(n) asm volatile("s_waitcnt vmcnt(" #n ")" ::: "memory")
#define PG8_WAIT_L(n) asm volatile("s_waitcnt lgkmcnt(" #n ")" ::: "memory")
#define PG8_BAR __builtin_amdgcn_s_barrier()
#define PG8_SCHED __builtin_amdgcn_sched_barrier(0)
    Unit cur, nxt; int ui = 0;
    if (!S.next(0, cur)) return;
    f32x4 acc[2][2][4][2];
#pragma unroll
    for (int a = 0; a < 2; ++a)
#pragma unroll
        for (int b = 0; b < 2; ++b)
#pragma unroll
            for (int m = 0; m < 4; ++m)
#pragma unroll
                for (int n = 0; n < 2; ++n) acc[a][b][m][n] = (f32x4){0.f, 0.f, 0.f, 0.f};
    bf16x8 At[4][2], B0[2][2], B1[2][2];
    const char* cA = cur.A; const char* cB = cur.B;
    PG8_STAGE(PG8_SB(0, 0), cB, voffB); PG8_STAGE(PG8_SB(0, 1), cB + hstepB, voffB); PG8_STAGE(PG8_SA(0, 0), cA, voffA); PG8_STAGE(PG8_SA(0, 1), cA + hstepA, voffA);
    if (wr == 1) PG8_BAR;
    PG8_WAIT_V(2); PG8_BAR;
    PG8_STAGE(PG8_SB(1, 0), cB + kstep, voffB); PG8_STAGE(PG8_SA(1, 0), cA + kstep, voffA); PG8_STAGE(PG8_SB(1, 1), cB + hstepB + kstep, voffB);
    PG8_WAIT_V(6); PG8_BAR;
    for (;;) {
        const bool has_next = S.next(ui + 1, nxt);
        const char* nA = has_next ? nxt.A : cA; const char* nB = has_next ? nxt.B : cB;
        for (int t = 0; t < nt; t += 2) {
            const bool last = (t == nt - 2);
            const char* a1 = cA + (size_t)(t + 1) * kstep;
            const char* a2 = last ? nA : cA + (size_t)(t + 2) * kstep; const char* b2 = last ? nB : cB + (size_t)(t + 2) * kstep;
            const char* a3 = a2 + kstep; const char* b3 = b2 + kstep;
            PG8_LDB(B0, 0, 0); PG8_LDB(B1, 0, 1); PG8_SCHED; PG8_LDA(At, 0, 0); PG8_STAGE(PG8_SA(1, 1), a1 + hstepA, voffA);
            PG8_WAIT_V(8); PG8_WAIT_L(0); PG8_BAR; PG8_MMA(0, 0, At, B0); PG8_MMA(0, 1, At, B1); PG8_BAR; PG8_SCHED;
            PG8_LDA(At, 0, 1); PG8_STAGE(PG8_SB(0, 0), b2, voffB); PG8_STAGE(PG8_SB(0, 1), b2 + hstepB, voffB); PG8_STAGE(PG8_SA(0, 0), a2, voffA);
            PG8_WAIT_V(8); PG8_WAIT_L(0); PG8_BAR; PG8_MMA(1, 0, At, B0); PG8_MMA(1, 1, At, B1); PG8_BAR; PG8_SCHED;
            PG8_LDB(B0, 1, 0); PG8_LDB(B1, 1, 1); PG8_SCHED; PG8_LDA(At, 1, 0); PG8_STAGE(PG8_SA(0, 1), a2 + hstepA, voffA);
            PG8_WAIT_V(8); PG8_WAIT_L(0); PG8_BAR; PG8_MMA(0, 0, At, B0); PG8_MMA(0, 1, At, B1); PG8_BAR; PG8_SCHED;
            PG8_LDA(At, 1, 1); PG8_STAGE(PG8_SB(1, 0), b3, voffB); PG8_STAGE(PG8_SB(1, 1), b3 + hstepB, voffB); PG8_STAGE(PG8_SA(1, 0), a3, voffA);
            PG8_WAIT_V(8); PG8_WAIT_L(0); PG8_BAR; PG8_MMA(1, 0, At, B0); PG8_MMA(1, 1, At, B1); PG8_BAR; PG8_SCHED;
        }
        if constexpr (ALIGN_EPI) { if (wr == 0) PG8_BAR; }
        E(acc, cur, wr, wc, fr, fq);
        if (!has_next) break;
#pragma unroll
        for (int a = 0; a < 2; ++a)
#pragma unroll
            for (int b = 0; b < 2; ++b)
#pragma unroll
                for (int m = 0; m < 4; ++m)
#pragma unroll
                    for (int n = 0; n < 2; ++n) acc[a][b][m][n] = (f32x4){0.f, 0.f, 0.f, 0.f};
        cur = nxt; cA = nA; cB = nB; ++ui;
        if constexpr (ALIGN_EPI) { if (wr == 1) PG8_BAR; }
    }
    PG8_WAIT_V(0);
    if constexpr (!ALIGN_EPI) { if (wr == 0) PG8_BAR; }
    PG8_BAR;
#undef PG8_SA
#undef PG8_SB
#undef PG8_STAGE
#undef PG8_LDA
#undef PG8_LDB
#undef PG8_MMA
#undef PG8_WAIT_V
#undef PG8_WAIT_L
#undef PG8_BAR
#undef PG8_SCHED
}
}

#ifndef WGM_P1A
#define WGM_P1A 3
#endif
#ifndef WGM_P1B
#define WGM_P1B 8
#endif
#ifndef WGM_P5
#define WGM_P5 2
#endif
using pg8::Unit;
struct SchedP1 {
    const char* XN; const char* W1T; int G, c;
    __device__ __forceinline__ bool next(int i, Unit& u) const {
        const int L = i * G + c; if (L >= 2048) return false;
        if (L < 1536) { pg8::tile_order(L, 64, 24, u.pm, u.pn, WGM_P1A); u.kind = (u.pn < 16) ? 0 : 1; u.A = XN + (size_t)u.pm * 256 * 1024 * 2; u.B = W1T + (size_t)u.pn * 256 * 1024 * 2; }
        else { pg8::tile_order(L - 1536, 8, 64, u.pm, u.pn, WGM_P1B); u.kind = 2; u.A = W1T + (size_t)(6144 + u.pm * 256) * 1024 * 2; u.B = XN + (size_t)u.pn * 256 * 1024 * 2; }
        return true;
    }
};
struct EpiP1 {
    static constexpr bool PERM = true;
    bf16_t* PROJ; bf16_t* GATES; bf16_t* VT; const float* bgate; unsigned* nk;
    __device__ __forceinline__ void operator()(const f32x4 (&acc)[2][2][4][2], const Unit& u, int wr, int wc, int fr, int fq) const {
        if (u.kind == 0 && u.pn >= 12) {
#pragma unroll
            for (int bj = 0; bj < 2; ++bj) { float mxv = 0.f;
#pragma unroll
                for (int ai = 0; ai < 2; ++ai)
#pragma unroll
                    for (int m = 0; m < 4; ++m) { const f32x4 a = acc[ai][bj][m][0], bq = acc[ai][bj][m][1];
                        float q = (a[0] * a[0] + a[1] * a[1]) + (a[2] * a[2] + a[3] * a[3]) + (bq[0] * bq[0] + bq[1] * bq[1]) + (bq[2] * bq[2] + bq[3] * bq[3]);
                        q += __shfl_xor(q, 16); q += __shfl_xor(q, 32); mxv = __builtin_fmaxf(mxv, q); }
                mxv = __builtin_fmaxf(mxv, __shfl_xor(mxv, 1)); mxv = __builtin_fmaxf(mxv, __shfl_xor(mxv, 2)); mxv = __builtin_fmaxf(mxv, __shfl_xor(mxv, 4)); mxv = __builtin_fmaxf(mxv, __shfl_xor(mxv, 8));
                if (fr == 0 && fq == 0) atomicMax(nk + (u.pm >= 32 ? 32 : 0) + ((u.pn - 12) * 256 + bj * 128 + wc * 32) / 32, __float_as_uint(mxv)); }
        }
        bf16_t* base; int ldc, colt; const float* bias = nullptr;
        if (u.kind == 0) { base = PROJ; ldc = PROJ_LD; colt = u.pn * 256; }
        else if (u.kind == 1) { base = GATES; ldc = 2048; colt = (u.pn - 16) * 256; bias = bgate + colt; }
        else { base = VT; ldc = MROWS; colt = u.pn * 256; }
        const int row0 = u.pm * 256 + wr * 64 + fr, col0 = colt + wc * 32 + 8 * fq;
        f32x4 bv[2][2];
#pragma unroll
        for (int bj = 0; bj < 2; ++bj)
#pragma unroll
            for (int n = 0; n < 2; ++n) bv[bj][n] = bias ? *(const f32x4*)(bias + wc * 32 + 8 * fq + bj * 128 + 4 * n) : (f32x4){0.f, 0.f, 0.f, 0.f};
#pragma unroll
        for (int ai = 0; ai < 2; ++ai)
#pragma unroll
            for (int m = 0; m < 4; ++m) { bf16_t* rowp = base + (size_t)(row0 + ai * 128 + m * 16) * ldc + col0;
#pragma unroll
                for (int bj = 0; bj < 2; ++bj) { f32x4 v0 = acc[ai][bj][m][0] + bv[bj][0], v1 = acc[ai][bj][m][1] + bv[bj][1];
                    if (u.kind == 1) {
#pragma unroll
                        for (int i = 0; i < 4; ++i) { v0[i] = fast_sigmoid(v0[i]); v1[i] = fast_sigmoid(v1[i]); } }
                    u32x4 w; w.x = cvtpk(v0[0], v0[1]); w.y = cvtpk(v0[2], v0[3]); w.z = cvtpk(v1[0], v1[1]); w.w = cvtpk(v1[2], v1[3]);
                    st16_wt(rowp + bj * 128, w); } }
    }
};
struct SchedP3 {
    const char* PROJ; const char* WBR; int G, c;
    __device__ __forceinline__ bool next(int i, Unit& u) const {
        const int pair = (i >> 1) * G + c; if (pair >= 256) return false;
        pg8::tile_order(pair, 64, 4, u.pm, u.pn); u.kind = i & 1;
        u.A = PROJ + ((size_t)u.pm * 256 * PROJ_LD + (u.kind ? PC_DFQ : PC_SBQ)) * 2; u.B = WBR + (size_t)(u.kind * 1024 + u.pn * 256) * 1024 * 2; return true;
    }
};
struct EpiP3 {
    static constexpr bool PERM = true;
    const bf16_t* GATES; bf16_t* Y;
    __device__ __forceinline__ void operator()(const f32x4 (&acc)[2][2][4][2], const Unit& u, int wr, int wc, int fr, int fq) const {
        const int row0 = u.pm * 256 + wr * 64 + fr, col0 = u.pn * 256 + wc * 32 + 8 * fq;
#pragma unroll
        for (int ai = 0; ai < 2; ++ai) {
            u32x4 gv[4][2], pv[4][2];
#pragma unroll
            for (int m = 0; m < 4; ++m) { const size_t row = (size_t)(row0 + ai * 128 + m * 16);
#pragma unroll
                for (int bj = 0; bj < 2; ++bj) { gv[m][bj] = *(const u32x4*)(GATES + row * 2048 + u.kind * 1024 + col0 + bj * 128);
                    if (u.kind) pv[m][bj] = *(const u32x4*)(Y + row * 1024 + col0 + bj * 128); } }
            __builtin_amdgcn_sched_barrier(0);
#pragma unroll
            for (int m = 0; m < 4; ++m) { const size_t row = (size_t)(row0 + ai * 128 + m * 16);
#pragma unroll
                for (int bj = 0; bj < 2; ++bj) { const u32x4 g = gv[m][bj];
                    bf16_t* yp = Y + row * 1024 + col0 + bj * 128;
                    const f32x4 v0 = acc[ai][bj][m][0], v1 = acc[ai][bj][m][1];
                    float o[8] = {v0[0] * bf2f(g.x & 0xffff), v0[1] * bf2f(g.x >> 16), v0[2] * bf2f(g.y & 0xffff), v0[3] * bf2f(g.y >> 16),
                                  v1[0] * bf2f(g.z & 0xffff), v1[1] * bf2f(g.z >> 16), v1[2] * bf2f(g.w & 0xffff), v1[3] * bf2f(g.w >> 16)};
                    if (u.kind) { const u32x4 p = pv[m][bj];
                        o[0] += bf2f(p.x & 0xffff); o[1] += bf2f(p.x >> 16); o[2] += bf2f(p.y & 0xffff); o[3] += bf2f(p.y >> 16);
                        o[4] += bf2f(p.z & 0xffff); o[5] += bf2f(p.z >> 16); o[6] += bf2f(p.w & 0xffff); o[7] += bf2f(p.w >> 16); }
                    u32x4 w; w.x = cvtpk(o[0], o[1]); w.y = cvtpk(o[2], o[3]); w.z = cvtpk(o[4], o[5]); w.w = cvtpk(o[6], o[7]);
                    *(u32x4*)yp = w; } }
            __builtin_amdgcn_sched_barrier(0);
        }
    }
};
struct SchedN1024 {
    const char* A; const char* B; size_t lda_b, ldb_b; int G, c;
    __device__ __forceinline__ bool next(int i, Unit& u) const {
        const int L = i * G + c; if (L >= 256) return false;
        pg8::tile_order(L, 64, 4, u.pm, u.pn); u.kind = 0; u.A = A + (size_t)u.pm * 256 * lda_b; u.B = B + (size_t)u.pn * 256 * ldb_b; return true;
    }
};
struct EpiRes {
    static constexpr bool PERM = false;
    const float* base; float* out; bf16_t* outb; float* ss;
    __device__ __forceinline__ void operator()(const f32x4 (&acc)[2][2][4][2], const Unit& u, int wr, int wc, int fr, int fq) const {
        const int col0 = u.pn * 256 + wc * 32 + 4 * fq;
#pragma unroll
        for (int ai = 0; ai < 2; ++ai) {
            f32x4 pre[4][2][2];
#pragma unroll
            for (int m = 0; m < 4; ++m) { const size_t off = (size_t)(u.pm * 256 + ai * 128 + wr * 64 + m * 16 + fr) * 1024 + col0;
#pragma unroll
                for (int bj = 0; bj < 2; ++bj)
#pragma unroll
                    for (int n = 0; n < 2; ++n) pre[m][bj][n] = *(const f32x4*)(base + off + bj * 128 + n * 16); }
            __builtin_amdgcn_sched_barrier(0);
#pragma unroll
            for (int m = 0; m < 4; ++m) { const int row = u.pm * 256 + ai * 128 + wr * 64 + m * 16 + fr; const size_t off = (size_t)row * 1024 + col0; float q = 0.f;
#pragma unroll
                for (int bj = 0; bj < 2; ++bj)
#pragma unroll
                    for (int n = 0; n < 2; ++n) { const f32x4 o = pre[m][bj][n] + acc[ai][bj][m][n];
                        if (out) *(f32x4*)(out + off + bj * 128 + n * 16) = o;
                        q += (o[0] * o[0] + o[1] * o[1]) + (o[2] * o[2] + o[3] * o[3]);
                        if (outb) { u32x2 w; w.x = cvtpk(o[0], o[1]); w.y = cvtpk(o[2], o[3]); *(u32x2*)(outb + off + bj * 128 + n * 16) = w; } }
                q += __shfl_xor(q, 16); q += __shfl_xor(q, 32);
                if (fq == 0) atomicAdd(ss + row, q); }
            __builtin_amdgcn_sched_barrier(0);
        }
    }
};
struct EpiFinal {
    static constexpr bool PERM = false;
    const bf16_t* base; float* out; float* ss; unsigned* cnt; const float* g;
    __device__ __forceinline__ void operator()(f32x4 (&acc)[2][2][4][2], const Unit& u, int wr, int wc, int fr, int fq) const {
        const int col0 = u.pn * 256 + wc * 32 + 4 * fq;
        u32x2 hbv[2][4][2][2];
#pragma unroll
        for (int ai = 0; ai < 2; ++ai)
#pragma unroll
            for (int m = 0; m < 4; ++m) { const size_t off = (size_t)(u.pm * 256 + ai * 128 + wr * 64 + m * 16 + fr) * 1024 + col0;
#pragma unroll
                for (int bj = 0; bj < 2; ++bj)
#pragma unroll
                    for (int n = 0; n < 2; ++n) hbv[ai][m][bj][n] = *(const u32x2*)(base + off + bj * 128 + n * 16); }
        __builtin_amdgcn_sched_barrier(0);
#pragma unroll
        for (int ai = 0; ai < 2; ++ai)
#pragma unroll
            for (int m = 0; m < 4; ++m) { const int row = u.pm * 256 + ai * 128 + wr * 64 + m * 16 + fr; float q = 0.f;
#pragma unroll
                for (int bj = 0; bj < 2; ++bj)
#pragma unroll
                    for (int n = 0; n < 2; ++n) { const u32x2 hb = hbv[ai][m][bj][n];
                        const f32x4 o = (f32x4){bf2f(hb.x & 0xffff), bf2f(hb.x >> 16), bf2f(hb.y & 0xffff), bf2f(hb.y >> 16)} + acc[ai][bj][m][n]; acc[ai][bj][m][n] = o;
                        q += (o[0] * o[0] + o[1] * o[1]) + (o[2] * o[2] + o[3] * o[3]); }
                q += __shfl_xor(q, 16); q += __shfl_xor(q, 32);
                if (fq == 0) atomicAdd(ss + row, q); }
        asm volatile("s_waitcnt vmcnt(0)" ::: "memory");
        unsigned* pc = cnt + 64 * u.pm;
        if (fr == 0 && fq == 0) __hip_atomic_fetch_add(pc, 1u, __ATOMIC_RELAXED, __HIP_MEMORY_SCOPE_AGENT);
        {   unsigned spins = 0;
            while ((unsigned)__builtin_amdgcn_readfirstlane(__hip_atomic_load(pc, __ATOMIC_RELAXED, __HIP_MEMORY_SCOPE_AGENT)) < 32u && ++spins < (1u << 20)) __builtin_amdgcn_s_sleep(2); }
        asm volatile("" ::: "memory");
        f32x4 gv[2][2];
#pragma unroll
        for (int bj = 0; bj < 2; ++bj)
#pragma unroll
            for (int n = 0; n < 2; ++n) gv[bj][n] = *(const f32x4*)(g + col0 + bj * 128 + n * 16);
#pragma unroll
        for (int ai = 0; ai < 2; ++ai)
#pragma unroll
            for (int m = 0; m < 4; ++m) { const int row = u.pm * 256 + ai * 128 + wr * 64 + m * 16 + fr; const size_t off = (size_t)row * 1024 + col0;
                const float tot = __hip_atomic_load(ss + row, __ATOMIC_RELAXED, __HIP_MEMORY_SCOPE_AGENT);
                const float rstd = __builtin_amdgcn_rsqf(tot * (1.0f / DM) + EPS);
#pragma unroll
                for (int bj = 0; bj < 2; ++bj)
#pragma unroll
                    for (int n = 0; n < 2; ++n) *(f32x4*)(out + off + bj * 128 + n * 16) = acc[ai][bj][m][n] * rstd * gv[bj][n]; }
    }
};
struct SchedP5 {
    const char* A; const char* B; int G, c;
    __device__ __forceinline__ bool next(int i, Unit& u) const {
        const int L = i * G + c; if (L >= 64 * 22) return false;
        pg8::tile_order(L, 64, 22, u.pm, u.pn, WGM_P5); u.kind = 0; u.A = A + (size_t)u.pm * 256 * 1024 * 2; u.B = B + (size_t)u.pn * 256 * 1024 * 2; return true;
    }
};
struct EpiP5 {
    static constexpr bool PERM = true;
    const float* ss; bf16_t* ACT;
    __device__ __forceinline__ void operator()(const f32x4 (&acc)[2][2][4][2], const Unit& u, int wr, int wc, int fr, int fq) const {
        const int col0 = u.pn * 128 + wc * 32 + 8 * fq;
#pragma unroll
        for (int ai = 0; ai < 2; ++ai)
#pragma unroll
            for (int m = 0; m < 4; ++m) { const int row = u.pm * 256 + ai * 128 + wr * 64 + m * 16 + fr; const float r = __builtin_amdgcn_rsqf(ss[row] * (1.0f / DM) + EPS);
                float o[8];
#pragma unroll
                for (int n = 0; n < 2; ++n)
#pragma unroll
                    for (int i = 0; i < 4; ++i) { const float g = acc[ai][0][m][n][i] * r, up = acc[ai][1][m][n][i] * r; o[4 * n + i] = g * fast_sigmoid(g) * up; }
                u32x4 w; w.x = cvtpk(o[0], o[1]); w.y = cvtpk(o[2], o[3]); w.z = cvtpk(o[4], o[5]); w.w = cvtpk(o[6], o[7]);
                *(u32x4*)(ACT + (size_t)row * DFF + col0) = w; }
    }
};

namespace att {
constexpr int KBYTES = 16384, VBYTES = 16384, TILE_BYTES = KBYTES + VBYTES;
constexpr int NBUF = 3, FLAG_OFF = NBUF * TILE_BYTES;
constexpr int Q_OFF = FLAG_OFF + 64;
static_assert(Q_OFF + 8 * 4096 <= 147456 - 64, "attention LDS map");
struct TileSrc { const bf16_t* k; const bf16_t* v; unsigned vp; };

__device__ __forceinline__ void tile_dma(const TileSrc& s, LAS unsigned char* buf, int wid, int lane) {
#pragma unroll
    for (int i = 0; i < 2; ++i) {
        const int piece = wid * 2 + i;
        { const int row = piece * 4 + (lane >> 4), cc = (lane & 15) ^ (row & 15); const unsigned off = (unsigned)(row * PROJ_LD + cc * 8);
          __builtin_amdgcn_global_load_lds((const unsigned*)(s.k + off), (LAS unsigned*)(buf + piece * 1024), 16, 0, 0); }
        { const int d = piece * 8 + (lane >> 3), cc = (lane & 7) ^ ((d >> 1) & 7); const unsigned off = (unsigned)d * s.vp + (unsigned)(cc * 8);
          __builtin_amdgcn_global_load_lds((const unsigned*)(s.v + off), (LAS unsigned*)(buf + KBYTES + piece * 1024), 16, 0, 0); }
    }
}
#define ATT_DMA_WAIT() asm volatile("s_waitcnt vmcnt(0)" ::: "memory")
#define ATT_WAIT_RING(newest_in_flight) do { if (newest_in_flight) asm volatile("s_waitcnt vmcnt(4)" ::: "memory"); else asm volatile("s_waitcnt vmcnt(0)" ::: "memory"); } while (0)
#define ATT_BAR() do { asm volatile("s_waitcnt lgkmcnt(0)" ::: "memory"); __builtin_amdgcn_s_barrier(); asm volatile("" ::: "memory"); } while (0)
__device__ __forceinline__ int pi32(int r) { return (r & 0x13) | ((r & 4) << 1) | ((r & 8) >> 1); }

struct Ctx {
    const bf16_t* PROJ; bf16_t* PROJW; const bf16_t* VT; const bf16_t* METAK; const bf16_t* METAV;
    const float* subln; const float* nk; unsigned* queue; float lam;
    LAS unsigned char* lds; int tid, lane, wid, r, h;
};
__device__ __forceinline__ TileSrc tile_src(const Ctx& c, int b, int j, int kcol, int vrow) {
    TileSrc s;
    if (j >= 0) { s.k = c.PROJ + ((size_t)(b * SEQ + 64 * j)) * PROJ_LD + kcol; s.v = c.VT + (size_t)vrow * MROWS + b * SEQ + 64 * j; s.vp = MROWS; }
    else { s.k = c.METAK + kcol; s.v = c.METAV + (size_t)vrow * 64; s.vp = 64; }
    return s;
}
__device__ __forceinline__ int k_addr(int sub, int r, int chunk) { const int row = 32 * sub + pi32(r); return row * 256 + ((chunk ^ (row & 15)) << 4); }
__device__ __forceinline__ int v_addr(int d, int chunk) { return KBYTES + d * 128 + ((chunk ^ ((d >> 1) & 7)) << 4); }

__device__ __forceinline__ void sb_unit(const Ctx& c, int b, int hd, int qb) {
    int lane = (int)__builtin_amdgcn_mbcnt_hi(~0u, __builtin_amdgcn_mbcnt_lo(~0u, 0u)); asm volatile("" : "+v"(lane));
    const int wid = c.wid, tid = wid * 64 + lane, r = lane & 31, h = lane >> 5;
    const int tq = 256 * qb + 32 * wid + r;
    const size_t qrow = (size_t)(b * SEQ + tq) * PROJ_LD + PC_SBQ + hd * 128;
    bf16x8 qf[8];
#pragma unroll
    for (int ks = 0; ks < 8; ++ks) qf[ks] = *(const bf16x8*)(c.PROJ + qrow + 16 * ks + 8 * h);
    f32x16 o[4];
#pragma unroll
    for (int dt = 0; dt < 4; ++dt) o[dt] = f32x16{};
    float C = 1.0f;
    const int jmax = 4 * qb + 3, NT = jmax + 2;
    const int kcolx = PC_SBK + hd * 128, vrow = hd * 128;
    LAS unsigned* flags = (LAS unsigned*)(c.lds + FLAG_OFF);
    if (tid == 0) { flags[0] = 0u; flags[1] = 0u; flags[2] = 0u; }
    {   const TileSrc s0 = tile_src(c, b, jmax, kcolx, vrow); tile_dma(s0, c.lds, wid, lane);
        const TileSrc s1 = tile_src(c, b, jmax - 1, kcolx, vrow); tile_dma(s1, c.lds + TILE_BYTES, wid, lane); }
    ATT_WAIT_RING(true); ATT_BAR();
    const int mydiag = 4 * qb + (wid >> 1);
    bool finished = false;
    int bcur = 0;
    for (int t = 0; t < NT; ++t) {
        const int j = (t <= jmax) ? jmax - t : -1;
        const LAS unsigned char* cur = c.lds + bcur * TILE_BYTES;
        const bool more = (t + 2 < NT);
        if (more) { const int jn = (t + 2 <= jmax) ? jmax - (t + 2) : -1; const int bn = (bcur >= 1) ? bcur - 1 : bcur + 2; const TileSrc s = tile_src(c, b, jn, kcolx, vrow); tile_dma(s, c.lds + bn * TILE_BYTES, wid, lane); }
        bcur = (bcur == 2) ? 0 : bcur + 1;
        const bool wave_active = (j < 0) || (j <= mydiag);
        if (wave_active && !finished) {
            const int lim = (j >= 0) ? (tq - 64 * j) : NMETA;
#pragma unroll 1
            for (int sub = 1; sub >= 0; --sub) {
                f32x16 s = f32x16{};
                bf16x8 ka[8], va[8];
#pragma unroll
                for (int ks = 0; ks < 8; ++ks) ka[ks] = *(const LAS bf16x8*)(cur + k_addr(sub, r, 2 * ks + h));
                __builtin_amdgcn_sched_barrier(0);
#pragma unroll
                for (int ks = 0; ks < 8; ++ks) s = __builtin_amdgcn_mfma_f32_32x32x16_bf16(ka[ks], qf[ks], s, 0, 0, 0);
                __builtin_amdgcn_sched_barrier(0);
                float av[16], fv[16];
#pragma unroll
                for (int reg = 0; reg < 16; ++reg) {
                    const int kap = 32 * sub + 16 * (reg >> 3) + 8 * h + (reg & 7);
                    const float z = __builtin_fminf(__builtin_fmaxf(s[reg], -115.f), 115.f);
                    const float e = __builtin_amdgcn_exp2f(-z); const float beta = __builtin_amdgcn_rcpf(1.0f + e); const float f = e * beta;
                    const bool valid = kap < lim; av[reg] = valid ? beta : 0.f; fv[reg] = valid ? f : 1.f;
                }
                float run = 1.f;
#pragma unroll
                for (int reg = 15; reg >= 8; --reg) { av[reg] *= run; run *= fv[reg]; }
                const float GU = run; run = 1.f;
#pragma unroll
                for (int reg = 7; reg >= 0; --reg) { av[reg] *= run; run *= fv[reg]; }
                const float GL = run;
                const float GUo = __shfl_xor(GU, 32), GLo = __shfl_xor(GL, 32);
                const float pU = GU * GUo, pL = GL * GLo;
                const float preU = h ? C : C * GUo, preL = h ? C * pU : (C * pU) * GLo;
                C = C * (pU * pL);
                u32x4 pf0, pf1;
                pf0.x = cvtpk(av[0] * preL, av[1] * preL); pf0.y = cvtpk(av[2] * preL, av[3] * preL); pf0.z = cvtpk(av[4] * preL, av[5] * preL); pf0.w = cvtpk(av[6] * preL, av[7] * preL);
                pf1.x = cvtpk(av[8] * preU, av[9] * preU); pf1.y = cvtpk(av[10] * preU, av[11] * preU); pf1.z = cvtpk(av[12] * preU, av[13] * preU); pf1.w = cvtpk(av[14] * preU, av[15] * preU);
                const bf16x8 p0 = __builtin_bit_cast(bf16x8, pf0), p1 = __builtin_bit_cast(bf16x8, pf1);
                __builtin_amdgcn_sched_barrier(0);
#pragma unroll
                for (int dt = 0; dt < 4; ++dt) { va[2 * dt] = *(const LAS bf16x8*)(cur + v_addr(32 * dt + r, 4 * sub + h)); va[2 * dt + 1] = *(const LAS bf16x8*)(cur + v_addr(32 * dt + r, 4 * sub + 2 + h)); }
                __builtin_amdgcn_sched_barrier(0);
#pragma unroll
                for (int dt = 0; dt < 4; ++dt) {
                    o[dt] = __builtin_amdgcn_mfma_f32_32x32x16_bf16(va[2 * dt], p0, o[dt], 0, 0, 0);
                    o[dt] = __builtin_amdgcn_mfma_f32_32x32x16_bf16(va[2 * dt + 1], p1, o[dt], 0, 0, 0);
                }
                __builtin_amdgcn_sched_barrier(0);
            }
            finished = __all(C < 1e-20f);
        }
        const int fw = t % 3;
        if (!finished && lane == 0) flags[fw] = 1u;
        ATT_WAIT_RING(more); ATT_BAR();
        const unsigned any_live = flags[fw];
        if (tid == 0) flags[(fw + 2) % 3] = 0u;
        if (SB_EARLY_EXIT && !any_live) break;
    }
    ATT_DMA_WAIT(); ATT_BAR();
    unsigned nxt = 0u; if (tid == 0) nxt = atomicAdd(c.queue, 1u);
    bf16_t* orow = c.PROJW + qrow;
#pragma unroll
    for (int dt = 0; dt < 4; ++dt)
#pragma unroll
        for (int g = 0; g < 4; ++g) { u32x2 w; w.x = cvtpk(o[dt][4 * g], o[dt][4 * g + 1]); w.y = cvtpk(o[dt][4 * g + 2], o[dt][4 * g + 3]); *(u32x2*)(orow + 32 * dt + 8 * g + 4 * h) = w; }
    if (tid == 0) flags[4] = nxt;
    ATT_BAR();
}

constexpr float DF_THR = 80.0f;
__device__ __forceinline__ float half_max(float v) { const auto rr = __builtin_amdgcn_permlane32_swap(__float_as_uint(v), __float_as_uint(v), false, false); return __builtin_fmaxf(__uint_as_float(rr[0]), __uint_as_float(rr[1])); }
__device__ __forceinline__ float half_sum(float v) { const auto rr = __builtin_amdgcn_permlane32_swap(__float_as_uint(v), __float_as_uint(v), false, false); return __uint_as_float(rr[0]) + __uint_as_float(rr[1]); }
template <int MODE, bool META>
__device__ __forceinline__ void df_tile(const LAS unsigned char* cur, const int j, const int r, const int h, const int cm, const float tqf, const float sl2, const LAS unsigned char* qp,
                                        f32x16 (&o)[4], float& mref, float& lsum, float& mlow, const float ubfar, bool& safe) {
    const float tqh = tqf - (float)(8 * h);
    const float cinit = (MODE == 0) ? 0.f : (-sl2 * tqh - mref);
    f32x16 s1, s0;
#pragma unroll
    for (int reg = 0; reg < 16; ++reg) { s1[reg] = cinit; s0[reg] = cinit; }
    bf16x8 ka[4], qf[4];
#pragma unroll
    for (int ks = 0; ks < 4; ++ks) qf[ks] = *(const LAS bf16x8*)(qp + ks * 1024);
#pragma unroll
    for (int kh = 0; kh < 2; ++kh) {
#pragma unroll
        for (int ks = 2 * kh; ks < 2 * kh + 2; ++ks) { ka[2 * (ks & 1)] = *(const LAS bf16x8*)(cur + k_addr(1, r, 8 * cm + 2 * ks + h)); ka[2 * (ks & 1) + 1] = *(const LAS bf16x8*)(cur + k_addr(0, r, 8 * cm + 2 * ks + h)); }
        __builtin_amdgcn_sched_barrier(0);
        __builtin_amdgcn_s_setprio(1);
#pragma unroll
        for (int ks = 2 * kh; ks < 2 * kh + 2; ++ks) {
            s1 = __builtin_amdgcn_mfma_f32_32x32x16_bf16(ka[2 * (ks & 1)], qf[ks], s1, 0, 0, 0);
            s0 = __builtin_amdgcn_mfma_f32_32x32x16_bf16(ka[2 * (ks & 1) + 1], qf[ks], s0, 0, 0, 0);
        }
        __builtin_amdgcn_sched_barrier(0);
    }
    __builtin_amdgcn_s_setprio(0);
    __builtin_amdgcn_sched_barrier(0);
    if (MODE == 0) {
        float mx = -INFINITY;
#pragma unroll
        for (int reg = 0; reg < 16; ++reg) {
            const float kc = (float)(16 * (reg >> 3) + (reg & 7));
            const float v1 = __builtin_fmaf(-sl2, __builtin_fabsf(tqh - (kc + 32.f)), s1[reg]);
            const float v0 = __builtin_fmaf(-sl2, __builtin_fabsf(tqh - kc), s0[reg]);
            s1[reg] = v1; s0[reg] = v0; mx = __builtin_fmaxf(mx, __builtin_fmaxf(v1, v0));
        }
        mx = half_max(mx); mlow = mx;
        const float mc = __builtin_fmaxf(mx, ubfar - 8.0f);
        safe = __all(mc - mx <= 90.0f);
        mref = safe ? mc : mx;
#pragma unroll
        for (int reg = 0; reg < 16; ++reg) { s1[reg] -= mref; s0[reg] -= mref; }
    } else {
#pragma unroll
        for (int reg = 0; reg < 16; ++reg) {
            const float kc = (float)(16 * (reg >> 3) + (reg & 7));
            float v1 = __builtin_fmaf(sl2, kc + 32.f, s1[reg]);
            float v0 = __builtin_fmaf(sl2, kc, s0[reg]);
            s1[reg] = v1; s0[reg] = v0;
        }
        if (MODE == 2) {
            float mx = -INFINITY;
#pragma unroll
            for (int reg = 0; reg < 16; ++reg) mx = __builtin_fmaxf(mx, __builtin_fmaxf(s1[reg], s0[reg]));
            mx = half_max(mx);
            const float dl = __builtin_fmaxf(mx, 0.f), sc = __builtin_amdgcn_exp2f(-dl);
            mref += dl; lsum *= sc;
#pragma unroll
            for (int reg = 0; reg < 16; ++reg) { s1[reg] -= dl; s0[reg] -= dl; }
#pragma unroll
            for (int dt = 0; dt < 4; ++dt) o[dt] *= sc;
        }
    }
    float ps = 0.f;
    if (META) {
#pragma unroll
        for (int reg = 0; reg < 8; ++reg) { const float p0 = __builtin_amdgcn_exp2f(s0[reg]); s0[reg] = p0; ps += p0; }
        lsum += ps;
        u32x4 wm; wm.x = cvtpk(s0[0], s0[1]); wm.y = cvtpk(s0[2], s0[3]); wm.z = cvtpk(s0[4], s0[5]); wm.w = cvtpk(s0[6], s0[7]);
        const bf16x8 pm = __builtin_bit_cast(bf16x8, wm);
        bf16x8 vm[4];
#pragma unroll
        for (int dt = 0; dt < 4; ++dt) vm[dt] = *(const LAS bf16x8*)(cur + v_addr(32 * dt + r, 0 + h));
        __builtin_amdgcn_sched_barrier(0);
#pragma unroll
        for (int dt = 0; dt < 4; ++dt) o[dt] = __builtin_amdgcn_mfma_f32_32x32x16_bf16(vm[dt], pm, o[dt], 0, 0, 0);
        __builtin_amdgcn_sched_barrier(0);
        return;
    }
#pragma unroll
    for (int reg = 0; reg < 16; ++reg) { const float p1 = __builtin_amdgcn_exp2f(s1[reg]), p0 = __builtin_amdgcn_exp2f(s0[reg]); s1[reg] = p1; s0[reg] = p0; ps += p1 + p0; }
    lsum += ps;
    u32x4 w1a, w1b, w0a, w0b;
    w1a.x = cvtpk(s1[0], s1[1]); w1a.y = cvtpk(s1[2], s1[3]); w1a.z = cvtpk(s1[4], s1[5]); w1a.w = cvtpk(s1[6], s1[7]);
    w1b.x = cvtpk(s1[8], s1[9]); w1b.y = cvtpk(s1[10], s1[11]); w1b.z = cvtpk(s1[12], s1[13]); w1b.w = cvtpk(s1[14], s1[15]);
    w0a.x = cvtpk(s0[0], s0[1]); w0a.y = cvtpk(s0[2], s0[3]); w0a.z = cvtpk(s0[4], s0[5]); w0a.w = cvtpk(s0[6], s0[7]);
    w0b.x = cvtpk(s0[8], s0[9]); w0b.y = cvtpk(s0[10], s0[11]); w0b.z = cvtpk(s0[12], s0[13]); w0b.w = cvtpk(s0[14], s0[15]);
    const bf16x8 p1a = __builtin_bit_cast(bf16x8, w1a), p1b = __builtin_bit_cast(bf16x8, w1b), p0a = __builtin_bit_cast(bf16x8, w0a), p0b = __builtin_bit_cast(bf16x8, w0b);
#define DF_VLOAD(dst, dt) do { dst[0] = *(const LAS bf16x8*)(cur + v_addr(32 * (dt) + r, 4 + h)); dst[1] = *(const LAS bf16x8*)(cur + v_addr(32 * (dt) + r, 6 + h)); \
        dst[2] = *(const LAS bf16x8*)(cur + v_addr(32 * (dt) + r, 0 + h)); dst[3] = *(const LAS bf16x8*)(cur + v_addr(32 * (dt) + r, 2 + h)); } while (0)
#define DF_PV(src, dt) do { o[dt] = __builtin_amdgcn_mfma_f32_32x32x16_bf16(src[0], p1a, o[dt], 0, 0, 0); o[dt] = __builtin_amdgcn_mfma_f32_32x32x16_bf16(src[1], p1b, o[dt], 0, 0, 0); \
        o[dt] = __builtin_amdgcn_mfma_f32_32x32x16_bf16(src[2], p0a, o[dt], 0, 0, 0); o[dt] = __builtin_amdgcn_mfma_f32_32x32x16_bf16(src[3], p0b, o[dt], 0, 0, 0); } while (0)
    bf16x8 vA[4], vB[2];
    __builtin_amdgcn_sched_barrier(0);
    DF_VLOAD(vA, 0); __builtin_amdgcn_sched_barrier(0);
    __builtin_amdgcn_s_setprio(1);
#define DF_VLOAD2(dst, dt) do { dst[0] = *(const LAS bf16x8*)(cur + v_addr(32 * (dt) + r, 4 + h)); dst[1] = *(const LAS bf16x8*)(cur + v_addr(32 * (dt) + r, 6 + h)); } while (0)
#define DF_VLOAD2B(dst, dt) do { dst[2] = *(const LAS bf16x8*)(cur + v_addr(32 * (dt) + r, 0 + h)); dst[3] = *(const LAS bf16x8*)(cur + v_addr(32 * (dt) + r, 2 + h)); } while (0)
#define DF_STAGE(dt, last) do { DF_VLOAD2(vB, (dt) + 1 - (last)); __builtin_amdgcn_sched_barrier(0); DF_PV(vA, dt); __builtin_amdgcn_sched_barrier(0); \
        if (!(last)) { vA[0] = vB[0]; vA[1] = vB[1]; DF_VLOAD2B(vA, (dt) + 1); __builtin_amdgcn_sched_barrier(0); } } while (0)
    DF_STAGE(0, 0); DF_STAGE(1, 0); DF_STAGE(2, 0); DF_PV(vA, 3);
#undef DF_VLOAD2
#undef DF_VLOAD2B
#undef DF_STAGE
#undef DF_VLOAD
#undef DF_PV
    __builtin_amdgcn_s_setprio(0);
    __builtin_amdgcn_sched_barrier(0);
}

__device__ __forceinline__ void df_unit(const Ctx& c, int b, int hd, int qb) {
    int lane = (int)__builtin_amdgcn_mbcnt_hi(~0u, __builtin_amdgcn_mbcnt_lo(~0u, 0u)); asm volatile("" : "+v"(lane));
    const int wid = c.wid, tid = wid * 64 + lane, r = lane & 31, h = lane >> 5, rg = wid & 3, cm = wid >> 2;
    const int tq = 128 * qb + 32 * rg + r;
    const size_t qrow = (size_t)(b * SEQ + tq) * PROJ_LD + PC_DFQ + hd * 128;
    bf16x8 qf[4];
#pragma unroll
    for (int ks = 0; ks < 4; ++ks) qf[ks] = *(const bf16x8*)(c.PROJ + qrow + 64 * cm + 16 * ks + 8 * h);
    float qn2 = 0.f;
#pragma unroll
    for (int ks = 0; ks < 4; ++ks)
#pragma unroll
        for (int i = 0; i < 8; ++i) { const float f = bf2f((unsigned short)qf[ks][i]); qn2 += f * f; }
    qn2 = half_sum(qn2);
    LAS unsigned char* qp = c.lds + Q_OFF + wid * 4096 + lane * 16;
#pragma unroll
    for (int ks = 0; ks < 4; ++ks) *(LAS bf16x8*)(qp + ks * 1024) = qf[ks];
    const float kmax2 = c.nk[b * 32 + hd * 4 + cm * 2] + c.nk[b * 32 + hd * 4 + cm * 2 + 1];
    const float bound0 = __builtin_sqrtf(qn2 * kmax2) * 1.02f;
    f32x16 o[4];
#pragma unroll
    for (int dt = 0; dt < 4; ++dt) o[dt] = f32x16{};
    float mref = 0.f, lsum = 0.f, mlow = 0.f;
    const float sl2 = __builtin_amdgcn_exp2f(-(float)(hd + 1)) * LOG2E;
    const int jmax = 2 * qb + 1, NT = jmax + 2;
    const int kcolx = PC_DFK + hd * 128, vrow = 1024 + hd * 128;
    LAS unsigned* flags = (LAS unsigned*)(c.lds + FLAG_OFF);
    if (tid == 0) { flags[0] = 0u; flags[1] = 0u; flags[2] = 0u; }
    {   const TileSrc s0 = tile_src(c, b, jmax, kcolx, vrow); tile_dma(s0, c.lds, wid, lane);
        const TileSrc s1 = tile_src(c, b, jmax - 1, kcolx, vrow); tile_dma(s1, c.lds + TILE_BYTES, wid, lane); }
    ATT_WAIT_RING(true); ATT_BAR();
    const int mychunk = 2 * qb + (rg >> 1);
    int bcur = 0, t = 0; bool blockdone = false, safe = false;
#define DF_STEP_BEGIN() \
        const int j = (t <= jmax) ? jmax - t : -1; \
        const LAS unsigned char* cur = c.lds + bcur * TILE_BYTES; \
        const bool more = (t + 2 < NT); \
        if (more) { const int jn = (t + 2 <= jmax) ? jmax - (t + 2) : -1; const int bn = (bcur >= 1) ? bcur - 1 : bcur + 2; const TileSrc s = tile_src(c, b, jn, kcolx, vrow); tile_dma(s, c.lds + bn * TILE_BYTES, wid, lane); } \
        bcur = (bcur == 2) ? 0 : bcur + 1;
#define DF_STEP_END(live) do { const int fw = t % 3; if ((live) && lane == 0) flags[fw] = 1u; ATT_WAIT_RING(more); ATT_BAR(); \
        const unsigned any_live = flags[fw]; if (tid == 0) flags[(fw + 2) % 3] = 0u; if (!any_live) blockdone = true; } while (0)
#define DF_TQF() ((float)(j >= 0 ? tq - 64 * j : tq + NMETA))
    for (; t < NT && !blockdone && ((t <= jmax) ? jmax - t : -1) > mychunk; ++t) { DF_STEP_BEGIN(); (void)j; (void)cur; DF_STEP_END(true); }
    {
        DF_STEP_BEGIN();
        const float dfar = (float)(mychunk >= 1 ? tq - (64 * (mychunk - 1) + 63) : tq + 1);
        int l0 = lane; asm volatile("" : "+v"(l0));
        df_tile<0, false>(cur, j, l0 & 31, l0 >> 5, cm, DF_TQF(), sl2, qp, o, mref, lsum, mlow, bound0 - sl2 * dfar, safe);
        DF_STEP_END(true); ++t;
    }
    if (safe) {
        int l1 = lane; asm volatile("" : "+v"(l1)); const int r1 = l1 & 31, h1 = l1 >> 5;
        bool fin = false;
        for (; t <= jmax && !blockdone; ++t) {
            const float dmin = (float)(tq - (64 * (jmax - t) + 63));
            if (__all(bound0 - sl2 * dmin - mlow < -DF_THR)) { fin = true; break; }
            DF_STEP_BEGIN();
            df_tile<1, false>(cur, j, r1, h1, cm, DF_TQF(), sl2, qp, o, mref, lsum, mlow, 0.f, safe);
            DF_STEP_END(true);
        }
        if (!fin && !blockdone && t < NT && !__all(bound0 - sl2 * (float)(tq + 1) - mlow < -DF_THR)) {
            DF_STEP_BEGIN();
            df_tile<1, true>(cur, j, r1, h1, cm, DF_TQF(), sl2, qp, o, mref, lsum, mlow, 0.f, safe);
            DF_STEP_END(true); ++t;
        }
    } else {
        int l2 = lane; asm volatile("" : "+v"(l2)); const int r2 = l2 & 31, h2 = l2 >> 5;
        bool fin = false;
        for (; t <= jmax && !blockdone; ++t) {
            const float dmin = (float)(tq - (64 * (jmax - t) + 63));
            if (__all(bound0 - sl2 * dmin - mlow < -DF_THR)) { fin = true; break; }
            DF_STEP_BEGIN();
            df_tile<2, false>(cur, j, r2, h2, cm, DF_TQF(), sl2, qp, o, mref, lsum, mlow, 0.f, safe);
            DF_STEP_END(true);
        }
        if (!fin && !blockdone && t < NT && !__all(bound0 - sl2 * (float)(tq + 1) - mlow < -DF_THR)) {
            DF_STEP_BEGIN();
            df_tile<2, true>(cur, j, r2, h2, cm, DF_TQF(), sl2, qp, o, mref, lsum, mlow, 0.f, safe);
            DF_STEP_END(true); ++t;
        }
    }
    for (; t < NT && !blockdone; ++t) { DF_STEP_BEGIN(); (void)j; (void)cur; DF_STEP_END(false); }
#undef DF_STEP_BEGIN
#undef DF_STEP_END
#undef DF_TQF
    ATT_DMA_WAIT(); ATT_BAR();
    unsigned nxt = 0u; if (tid == 0) nxt = atomicAdd(c.queue, 1u);
    const float L = half_sum(lsum);
    const float inv = (cm == 0 ? 1.0f : c.lam) / L;
    LAS float* xch = (LAS float*)(c.lds + rg * 16384);
    if (cm == 1) {
#pragma unroll
        for (int dt = 0; dt < 4; ++dt)
#pragma unroll
            for (int reg = 0; reg < 16; ++reg) xch[(dt * 16 + reg) * 64 + lane] = o[dt][reg] * inv;
    }
    ATT_BAR();
    if (cm == 0) {
        float ss = 0.f;
#pragma unroll
        for (int dt = 0; dt < 4; ++dt)
#pragma unroll
            for (int reg = 0; reg < 16; ++reg) { const float v = o[dt][reg] * inv - xch[(dt * 16 + reg) * 64 + lane]; o[dt][reg] = v; ss += v * v; }
        ss = half_sum(ss);
        const float rs = __builtin_amdgcn_rsqf(ss * (1.0f / 128.0f) + EPS) * 0.8f;
        bf16_t* orow = c.PROJW + qrow;
#pragma unroll
        for (int dt = 0; dt < 4; ++dt)
#pragma unroll
            for (int g = 0; g < 4; ++g) { const int d0 = 32 * dt + 8 * g + 4 * h; const f32x4 gn = *(const f32x4*)(c.subln + d0);
                u32x2 w; w.x = cvtpk(o[dt][4 * g] * rs * gn[0], o[dt][4 * g + 1] * rs * gn[1]); w.y = cvtpk(o[dt][4 * g + 2] * rs * gn[2], o[dt][4 * g + 3] * rs * gn[3]);
                *(u32x2*)(orow + d0) = w; }
    }
    if (tid == 0) flags[4] = nxt;
    ATT_BAR();
}
}


#define XB_TMO      128
#define XB_XCNT(j)  (256  + 64 * (j))
#define XB_XSUB(j)  (1280 + 64 * (j))
#define XB_XGEN(j)  (2304 + 64 * (j))
#define XB_TOP      3328
#define XB_TOPGEN   3392
#define XCD_BAR_WORDS 3456
#define XB_SPIN_CAP (1u << 22)
__device__ __forceinline__ unsigned xb_ld(unsigned* p)              { return __hip_atomic_load(p, __ATOMIC_RELAXED, __HIP_MEMORY_SCOPE_AGENT); }
__device__ __forceinline__ unsigned xb_add(unsigned* p, unsigned v) { return __hip_atomic_fetch_add(p, v, __ATOMIC_RELAXED, __HIP_MEMORY_SCOPE_AGENT); }
__device__ __forceinline__ unsigned xb_xcc_id() { return (unsigned)__builtin_amdgcn_s_getreg((3 << 11) | 20) & 0xFu; }
#define XB_SPIN(cond, bar) do { unsigned _sp = 0; while (cond) { __builtin_amdgcn_s_sleep(1); \
    if ((++_sp & 255u) == 0u) { if (xb_ld(&(bar)[XB_TMO])) break; if (_sp > XB_SPIN_CAP) { atomicAdd(&(bar)[XB_TMO], 1u); break; } } } } while (0)
struct XcdBarrier { unsigned* bar; unsigned x; volatile LAS unsigned* st; };
__device__ __forceinline__ XcdBarrier xcd_barrier_post(unsigned* bar, volatile LAS unsigned* st) {
    XcdBarrier b; b.bar = bar; b.x = xb_xcc_id(); b.st = st;
    if (threadIdx.x == 0) (void)xb_add(&bar[XB_XCNT(b.x)], 1u);
    return b;
}
__device__ __forceinline__ void xcd_barrier_complete(unsigned* bar, unsigned x, unsigned& nloc, unsigned& nx) {
    const unsigned G = gridDim.x * gridDim.y * gridDim.z;
    unsigned sum, cnt, mine, sp = 0u;
    for (;;) {
        sum = 0u; cnt = 0u; mine = 0u;
#pragma unroll
        for (unsigned j = 0; j < 16; ++j) { const unsigned c = xb_ld(&bar[XB_XCNT(j)]); sum += c; cnt += (c > 0u) ? 1u : 0u; mine = (j == x) ? c : mine; }
        if (sum == G) break;
        __builtin_amdgcn_s_sleep(1);
        if ((++sp & 255u) == 0u) { if (xb_ld(&bar[XB_TMO])) break; if (sp > XB_SPIN_CAP) { atomicAdd(&bar[XB_TMO], 1u); break; } }
    }
    nloc = mine > 0u ? mine : 1u; nx = cnt > 0u ? cnt : 1u;
}
__device__ __forceinline__ void xcd_barrier(const XcdBarrier& b) {
    asm volatile("s_waitcnt vmcnt(0)" ::: "memory");
    __syncthreads();
    if (threadIdx.x == 0) {
        unsigned* bar = b.bar;
        __builtin_amdgcn_s_waitcnt(0);
        unsigned nloc = b.st[0], nx = b.st[1];
        if (nloc == 0u) { xcd_barrier_complete(bar, b.x, nloc, nx); b.st[0] = nloc; b.st[1] = nx; }
        const unsigned old = xb_add(&bar[XB_XSUB(b.x)], 1u);
        const unsigned gen = old / nloc;
        if (old + 1u == (gen + 1u) * nloc) {
            __builtin_amdgcn_fence(__ATOMIC_RELEASE, "agent");
            asm volatile("s_waitcnt vmcnt(0)" ::: "memory");
            const unsigned og = xb_add(&bar[XB_TOP], 1u);
            const unsigned tg = og / nx;
            if (og + 1u == (tg + 1u) * nx) xb_add(&bar[XB_TOPGEN], 1u);
            else XB_SPIN(xb_ld(&bar[XB_TOPGEN]) == tg, bar);
            __builtin_amdgcn_fence(__ATOMIC_ACQUIRE, "agent");
            xb_add(&bar[XB_XGEN(b.x)], 1u);
            asm volatile("s_waitcnt vmcnt(0)" ::: "memory");
        } else {
            XB_SPIN(xb_ld(&bar[XB_XGEN(b.x)]) == gen, bar);
            __builtin_amdgcn_fence(__ATOMIC_ACQUIRE, "agent");
            asm volatile("s_waitcnt vmcnt(0)" ::: "memory");
        }
    }
    __syncthreads();
}

__device__ __forceinline__ void transpose_item(const float* W, int ldw, int k0, int n0, bf16_t* WT, int ldwt, int drow0, int dcol0, int dup_off, float scale, const float* kscale, LAS float* scr, int lane) {
#pragma unroll
    for (int i = 0; i < 32; ++i) { const int kk = 2 * i + (lane >> 5); float v = W[(size_t)(k0 + kk) * ldw + n0 + (lane & 31)] * scale; if (kscale) v *= kscale[k0 + kk]; scr[kk * 33 + (lane & 31)] = v; }
    asm volatile("s_waitcnt lgkmcnt(0)" ::: "memory");
    const int cc = lane & 7;
#pragma unroll
    for (int jj = 0; jj < 4; ++jj) { const int n = (lane >> 3) + 8 * jj; const LAS float* s = scr + (8 * cc) * 33 + n;
        u32x4 ov; ov.x = cvtpk(s[0 * 33], s[1 * 33]); ov.y = cvtpk(s[2 * 33], s[3 * 33]); ov.z = cvtpk(s[4 * 33], s[5 * 33]); ov.w = cvtpk(s[6 * 33], s[7 * 33]);
        bf16_t* dst = WT + (size_t)(drow0 + n) * ldwt + dcol0 + k0 + 8 * cc;
        *(u32x4*)dst = ov; if (dup_off) *(u32x4*)(dst + dup_off) = ov; }
    asm volatile("s_waitcnt lgkmcnt(0)" ::: "memory");
}

constexpr int LDS_BYTES = 147456, LDS_MISC_OFF = LDS_BYTES - 64;
__device__ __forceinline__ void tr_load(const float* W, int ldw, int k0, int n0, float scale, float (&v)[32], int lane, const float* kscale = nullptr) {
#pragma unroll
    for (int i = 0; i < 32; ++i) { const int kk = 2 * i + (lane >> 5); v[i] = W[(size_t)(k0 + kk) * ldw + n0 + (lane & 31)] * scale; }
    if (kscale) {
#pragma unroll
        for (int i = 0; i < 32; ++i) v[i] *= kscale[k0 + 2 * i + (lane >> 5)];
    }
}
__device__ __forceinline__ void tr_store(const float (&v)[32], bf16_t* WT, int ldwt, int drow0, int k0, LAS float* scr, int lane) {
#pragma unroll
    for (int i = 0; i < 32; ++i) { const int kk = 2 * i + (lane >> 5); scr[kk * 33 + (lane & 31)] = v[i]; }
    asm volatile("s_waitcnt lgkmcnt(0)" ::: "memory");
    const int cc = lane & 7;
#pragma unroll
    for (int jj = 0; jj < 4; ++jj) { const int n = (lane >> 3) + 8 * jj; const LAS float* sp = scr + (8 * cc) * 33 + n;
        u32x4 ov; ov.x = cvtpk(sp[0 * 33], sp[1 * 33]); ov.y = cvtpk(sp[2 * 33], sp[3 * 33]); ov.z = cvtpk(sp[4 * 33], sp[5 * 33]); ov.w = cvtpk(sp[6 * 33], sp[7 * 33]);
        *(u32x4*)(WT + (size_t)(drow0 + n) * ldwt + k0 + 8 * cc) = ov; }
    asm volatile("s_waitcnt lgkmcnt(0)" ::: "memory");
}
__device__ __forceinline__ void w1t_item(int it, const float* w_in, const float* w_gate, const float*& src, int& ldw, int& k0, int& n0, int& drow0, float& sc) {
    const int kb = it >> 8, nb = it & 255, blk = nb >> 5, nin = (nb & 31) * 32;
    const float cq_sb = LOG2E * 0.08838834764831845f, cq_df = LOG2E * 0.125f;
    sc = 1.f; src = w_in; ldw = 6144;
    switch (blk) {
        case 0: n0 = 0 + nin; sc = cq_sb; break;
        case 1: n0 = 1024 + nin; break;
        case 2: n0 = 3072 + nin; sc = cq_df; break;
        case 3: n0 = 4096 + nin; break;
        case 4: src = w_gate; ldw = 2048; n0 = nin; break;
        case 5: src = w_gate; ldw = 2048; n0 = 1024 + nin; break;
        case 6: n0 = 2048 + nin; break;
        default: n0 = 5120 + nin; break;
    }
    k0 = kb * 64; drow0 = nb * 32;
}

struct Args { const float* in[19]; float* out; unsigned char* ws; int ph_lo, ph_hi; };

__global__ void __launch_bounds__(NTHREADS, 2) fwd_kernel(Args args) {
    extern __shared__ __attribute__((aligned(16))) unsigned char lds_raw[];
    LAS unsigned char* lds = (LAS unsigned char*)lds_raw;
    const int tid = threadIdx.x, lane = tid & 63, wid = __builtin_amdgcn_readfirstlane(tid >> 6);
    const int G = gridDim.x, bx = blockIdx.x;
    unsigned char* ws = args.ws;
    const float* x = args.in[0];
    bf16_t* W1T = (bf16_t*)(ws + WS_W1T); bf16_t* XN = (bf16_t*)(ws + WS_XN); bf16_t* PROJ = (bf16_t*)(ws + WS_PROJ); bf16_t* GATES = (bf16_t*)(ws + WS_GATES);
    bf16_t* METAK = (bf16_t*)(ws + WS_METAK); bf16_t* METAV = (bf16_t*)(ws + WS_METAV);
    bf16_t* WBR = (bf16_t*)(ws + WS_WBR); bf16_t* WOUT2 = (bf16_t*)(ws + WS_WOUT2); bf16_t* WFFN = (bf16_t*)(ws + WS_WFFN); bf16_t* WDOWN = (bf16_t*)(ws + WS_WDOWN);
    bf16_t* H1B = (bf16_t*)(ws + WS_H1B); bf16_t* ACT = (bf16_t*)(ws + WS_ACT); float* H1 = (float*)(ws + WS_H1);
    float* SS1 = (float*)(ws + CTL_SS1); float* SS2 = (float*)(ws + CTL_SS2);
    bf16_t* VT = (bf16_t*)args.out; bf16_t* Y = (bf16_t*)args.out;
    const int gw = bx * NWAVES + wid, NGW = G * NWAVES;
    const int lo = args.ph_lo, hi = args.ph_hi;
#define IN(k) (lo <= (k) && (k) < hi)
#ifdef PROBE_A
    unsigned long long* tsw = (unsigned long long*)(ws + 2048);
#define STAMP(i) do { if (bx == 0 && tid == 0) tsw[i] = __builtin_amdgcn_s_memrealtime(); } while (0)
#else
#define STAMP(i) do {} while (0)
#endif
#if MK_N_LAUNCHES == 1
    volatile LAS unsigned* bar_st = (volatile LAS unsigned*)(lds + LDS_MISC_OFF);
    if (tid < 2) bar_st[tid] = 0u;
    __syncthreads();
    const XcdBarrier gbar = xcd_barrier_post((unsigned*)(ws + CTL_BAR), bar_st);
    if (args.ph_lo < 0) cg::this_grid().sync();
#define GRID_BAR() xcd_barrier(gbar)
#else
#define GRID_BAR() do {} while (0)
#endif

    STAMP(0);
    if (IN(0)) {
        LAS float* scr = (LAS float*)(lds + wid * 16384);
        const float* w_in = args.in[3]; const float* w_gate = args.in[4];
        {   const bool split = (G >= 256);
            const int cw = split ? (bx >= 128 ? (bx - 128) * NWAVES + wid : -1) : gw, NCW = split ? (G - 128) * NWAVES : NGW;
            if (cw >= 0) for (int it = cw; it < 16 * 256; it += 2 * NCW) {
                const bool hasB = (it + NCW < 16 * 256);
                const float* sa; const float* sb; int la, lb, ka, kb2, na, nb2, da, db; float ca, cb;
                w1t_item(it, w_in, w_gate, sa, la, ka, na, da, ca);
                w1t_item(hasB ? it + NCW : it, w_in, w_gate, sb, lb, kb2, nb2, db, cb);
                float va[32], vb[32];
                tr_load(sa, la, ka, na, ca, va, lane);
                if (hasB) tr_load(sb, lb, kb2, nb2, cb, vb, lane);
                tr_store(va, W1T, 1024, da, ka, scr, lane);
                if (hasB) tr_store(vb, W1T, 1024, db, kb2, scr, lane);
            }
        }
        {   const float* g = args.in[2];
            f32x4 gv[4];
#pragma unroll
            for (int jj = 0; jj < 4; ++jj) gv[jj] = *((const f32x4*)g + lane + 64 * jj);
            for (int m0 = gw; m0 < MROWS; m0 += 8 * NGW) {
                f32x4 v[8][4];
#pragma unroll
                for (int q = 0; q < 8; ++q) { const int m = m0 + q * NGW; if (m < MROWS) { const f32x4* xr = (const f32x4*)(x + (size_t)m * DM) + lane;
#pragma unroll
                    for (int jj = 0; jj < 4; ++jj) v[q][jj] = xr[64 * jj]; } }
#pragma unroll
                for (int q = 0; q < 8; ++q) { const int m = m0 + q * NGW; if (m < MROWS) { float s = 0.f;
#pragma unroll
                    for (int jj = 0; jj < 4; ++jj) s += (v[q][jj].x * v[q][jj].x + v[q][jj].y * v[q][jj].y) + (v[q][jj].z * v[q][jj].z + v[q][jj].w * v[q][jj].w);
                    const float rstd = __builtin_amdgcn_rsqf(wave_sum(s) * (1.0f / DM) + EPS);
                    u32x2* o8 = (u32x2*)(XN + (size_t)m * DM) + lane;
#pragma unroll
                    for (int jj = 0; jj < 4; ++jj) { u32x2 w; w.x = cvtpk(v[q][jj].x * rstd * gv[jj].x, v[q][jj].y * rstd * gv[jj].y); w.y = cvtpk(v[q][jj].z * rstd * gv[jj].z, v[q][jj].w * rstd * gv[jj].w); o8[64 * jj] = w; } } }
            }
        }
        if (bx < 128) {
            __syncthreads();
            LAS float* xm = (LAS float*)lds;
            LAS float* part = (LAS float*)(lds + 65536);
            LAS float* res = (LAS float*)(lds + 65536 + 32768);
            const float* meta = args.in[1]; const float* g = args.in[2];
            for (int rr = 0; rr < 2; ++rr) { const int row = 2 * wid + rr; const f32x4* xr = (const f32x4*)(meta + (size_t)row * DM) + lane; f32x4 v[4]; float s = 0.f;
#pragma unroll
                for (int jj = 0; jj < 4; ++jj) { v[jj] = xr[64 * jj]; s += (v[jj].x * v[jj].x + v[jj].y * v[jj].y) + (v[jj].z * v[jj].z + v[jj].w * v[jj].w); }
                const float rstd = __builtin_amdgcn_rsqf(wave_sum(s) * (1.0f / DM) + EPS);
#pragma unroll
                for (int jj = 0; jj < 4; ++jj) { const f32x4 gg = *((const f32x4*)g + lane + 64 * jj); f32x4 w = v[jj] * rstd * gg; *(LAS f32x4*)(xm + row * 1024 + 4 * (lane + 64 * jj)) = w; } }
            __syncthreads();
            const int cl = tid & 31, ksl = tid >> 5, blk = bx >> 5, col = (bx & 31) * 32 + cl;
            const int srcc = (blk == 0 ? 1024 : blk == 1 ? 2048 : blk == 2 ? 4096 : 5120) + col;
            float acc[16];
#pragma unroll
            for (int i = 0; i < 16; ++i) acc[i] = 0.f;
#pragma unroll 8
            for (int k = ksl * 64; k < ksl * 64 + 64; ++k) { const float w = w_in[(size_t)k * 6144 + srcc];
#pragma unroll
                for (int i = 0; i < 16; ++i) acc[i] = __builtin_fmaf(xm[i * 1024 + k], w, acc[i]); }
#pragma unroll
            for (int i = 0; i < 16; ++i) part[(ksl * 16 + i) * 32 + cl] = acc[i];
            __syncthreads();
            {   const int i = tid >> 5; float v = 0.f;
#pragma unroll
                for (int ks2 = 0; ks2 < 16; ++ks2) v += part[(ks2 * 16 + i) * 32 + cl];
                res[i * 32 + cl] = v;
                if (blk == 2) { float q = v * v; q += __shfl_xor(q, 1); q += __shfl_xor(q, 2); q += __shfl_xor(q, 4); q += __shfl_xor(q, 8); q += __shfl_xor(q, 16);
                    if (cl == 0) { unsigned* nk = (unsigned*)(ws + CTL_NK); const int id = bx & 31; atomicMax(nk + id, __float_as_uint(q)); atomicMax(nk + 32 + id, __float_as_uint(q)); } }
                if (blk == 0 || blk == 2) {
                    const int dcol = (blk == 2 ? PC_DFK : PC_SBK) + col;
                    METAK[(size_t)i * PROJ_LD + dcol] = (bf16_t)(cvtpk(v, 0.f) & 0xffffu);
#pragma unroll
                    for (int q3 = 1; q3 < 4; ++q3) METAK[(size_t)(16 * q3 + i) * PROJ_LD + dcol] = (bf16_t)0;
                }
            }
            __syncthreads();
            if ((blk == 1 || blk == 3) && tid < 32) {
                float v[16];
#pragma unroll
                for (int i = 0; i < 16; ++i) v[i] = res[i * 32 + cl];
                bf16_t* dst = METAV + (size_t)((blk == 3 ? 1024 : 0) + col) * 64;
                u32x4 w0, w1; const u32x4 z = {0u, 0u, 0u, 0u};
                w0.x = cvtpk(v[0], v[1]); w0.y = cvtpk(v[2], v[3]); w0.z = cvtpk(v[4], v[5]); w0.w = cvtpk(v[6], v[7]);
                w1.x = cvtpk(v[8], v[9]); w1.y = cvtpk(v[10], v[11]); w1.z = cvtpk(v[12], v[13]); w1.w = cvtpk(v[14], v[15]);
                *(u32x4*)(dst) = w0; *(u32x4*)(dst + 8) = w1;
#pragma unroll
                for (int i = 2; i < 8; ++i) *(u32x4*)(dst + 8 * i) = z;
            }
        }
        if (IN(1)) GRID_BAR();
        STAMP(1);
    }

    if (IN(1)) {
        SchedP1 S{(const char*)XN, (const char*)W1T, G, bx};
        EpiP1 E{PROJ, GATES, VT, args.in[5], (unsigned*)(ws + CTL_NK)};
        pg8::gemm_phase<EpiP1, SchedP1, true>(lds, 1024, 1024, 1024, S, E);
        if (IN(2)) GRID_BAR();
        STAMP(2);
    }

    if (IN(2)) {
        {   LAS float* scr = (LAS float*)(lds + wid * 16384);
            const float* w_br_sb = args.in[11]; const float* w_br_df = args.in[12]; const float* w_out = args.in[13]; const float* gffn = args.in[14];
            const float* w_fg = args.in[15]; const float* w_fu = args.in[16]; const float* w_fd = args.in[17];
            constexpr int I_BR = 16 * 32, I_FFN = 16 * 176, I_DN = 44 * 32, I_ALL = 3 * I_BR + I_FFN + I_DN;
#define CONV_ITEM(it_, src, dst, ksc, ldw, ldwt, k0, n0, drow0) do { const int it = (it_); ksc = nullptr; \
                if (it < 3 * I_BR) { const int w = it / I_BR, q = it % I_BR; src = (w == 0) ? w_br_sb : (w == 1) ? w_br_df : w_out; dst = (w == 2) ? WOUT2 : WBR; \
                    ldw = 1024; ldwt = 1024; k0 = (q >> 5) * 64; n0 = (q & 31) * 32; drow0 = (w == 1 ? 1024 : 0) + n0; } \
                else if (it < 3 * I_BR + I_FFN) { const int q = it - 3 * I_BR, kb = q / 176, nb = q % 176, R = nb * 32, p = R >> 8, rr = R & 255; \
                    src = (rr < 128) ? w_fg : w_fu; dst = WFFN; ksc = gffn; ldw = DFF; ldwt = 1024; k0 = kb * 64; n0 = 128 * p + (rr & 127); drow0 = R; } \
                else { const int q = it - 3 * I_BR - I_FFN; src = w_fd; dst = WDOWN; ldw = 1024; ldwt = DFF; k0 = (q >> 5) * 64; n0 = (q & 31) * 32; drow0 = n0; } } while (0)
            for (int it0 = gw; it0 < I_ALL; it0 += 2 * NGW) {
                const bool hasB = (it0 + NGW < I_ALL);
                const float *sa, *sb, *ga, *gb; bf16_t *da, *db; int la, lb, lta, ltb, ka, kb2, na, nb2, ra, rb;
                CONV_ITEM(it0, sa, da, ga, la, lta, ka, na, ra);
                CONV_ITEM(hasB ? it0 + NGW : it0, sb, db, gb, lb, ltb, kb2, nb2, rb);
                float va[32], vb[32];
                tr_load(sa, la, ka, na, 1.f, va, lane, ga);
                if (hasB) tr_load(sb, lb, kb2, nb2, 1.f, vb, lane, gb);
                tr_store(va, da, lta, ra, ka, scr, lane);
                if (hasB) tr_store(vb, db, ltb, rb, kb2, scr, lane);
            }
#undef CONV_ITEM
        }
        __syncthreads();
        att::Ctx c; c.PROJ = PROJ; c.PROJW = PROJ; c.VT = VT; c.METAK = METAK; c.METAV = METAV; c.subln = args.in[10]; c.nk = (const float*)(ws + CTL_NK); c.queue = (unsigned*)(ws + CTL_QUEUE); c.lds = lds; c.tid = tid; c.lane = lane; c.wid = wid; c.r = lane & 31; c.h = lane >> 5;
        {   const float a1 = args.in[6][lane] * args.in[7][lane], a2 = args.in[8][lane] * args.in[9][lane];
            const float lamv = __expf(wave_sum(a1)) - __expf(wave_sum(a2)) + 0.2f; c.lam = __uint_as_float(__builtin_amdgcn_readfirstlane(__float_as_uint(lamv))); }
        LAS unsigned* flags = (LAS unsigned*)(lds + att::FLAG_OFF);
        if (tid < 8) flags[tid] = 0u;
        __syncthreads();
        unsigned* queue = (unsigned*)(ws + CTL_QUEUE);
        if (tid == 0) flags[4] = atomicAdd(queue, 1u);
        __syncthreads();
        for (;;) {
            const unsigned u = flags[4];
            __syncthreads();
            if (u >= 1536u) break;
            if (u < 1024u) {
#ifndef NO_DF
                const int qb = 63 - (int)(u >> 4), hb = (int)(u & 15), hd = 7 - (hb >> 1), b = hb & 1; att::df_unit(c, b, hd, qb);
#endif
            }
            else {
#ifndef NO_SB
                const unsigned v = u - 1024u; const int qb = 31 - (int)(v >> 4), hb = (int)(v & 15), hd = hb >> 1, b = hb & 1; att::sb_unit(c, b, hd, qb);
#endif
            }
        }
        if (IN(3)) GRID_BAR();
        STAMP(3);
    }

    if (IN(3)) {
        SchedP3 S{(const char*)PROJ, (const char*)WBR, G, bx};
        EpiP3 E{GATES, Y};
        pg8::gemm_phase<EpiP3, SchedP3, false>(lds, 1024, PROJ_LD, 1024, S, E);
        if (IN(4)) GRID_BAR();
        STAMP(4);
    }

    if (IN(4)) {
        SchedN1024 S{(const char*)Y, (const char*)WOUT2, (size_t)1024 * 2, (size_t)1024 * 2, G, bx};
        EpiRes E{x, nullptr, H1B, SS1};
        pg8::gemm_phase<EpiRes, SchedN1024, true>(lds, 1024, 1024, 1024, S, E);
        if (IN(5)) GRID_BAR();
        STAMP(5);
    }

    if (IN(5)) {
        SchedP5 S{(const char*)H1B, (const char*)WFFN, G, bx};
        EpiP5 E{SS1, ACT};
        pg8::gemm_phase<EpiP5, SchedP5, true>(lds, 1024, 1024, 1024, S, E);
        if (IN(6)) GRID_BAR();
        STAMP(6);
    }

    if (IN(6)) {
        SchedN1024 S{(const char*)ACT, (const char*)WDOWN, (size_t)DFF * 2, (size_t)DFF * 2, G, bx};
        EpiFinal E{H1B, args.out, SS2, (unsigned*)(ws + CTL_PCNT), args.in[18]};
        pg8::gemm_phase<EpiFinal, SchedN1024, true>(lds, DFF, DFF, DFF, S, E);
        STAMP(7);
#ifdef PROBE_A
        GRID_BAR();
        if (bx == 0) { const unsigned long long d = tsw[PROBE_B] - tsw[PROBE_A]; const int K = (int)(d / 4); for (int i = tid; i < K && i < MROWS * DM; i += NTHREADS) args.out[i] += 0.1f; }
#endif
    }

#undef IN
}

extern "C" void kernel_launch(void* const* d_in, const int* in_sizes, int n_in, void* d_out, int out_size, void* d_ws, size_t ws_size, hipStream_t stream) {
    static int grid = 0;
    if (grid == 0) {
        if (n_in != 19 || out_size != MROWS * DM || ws_size < WS_END) { fprintf(stderr, "kernel_launch: unexpected shapes (n_in %d out %d ws %zu)\n", n_in, out_size, ws_size); grid = -1; return; }
        int dev = 0, cus = 0, per_cu = 0;
        hipGetDevice(&dev); hipDeviceGetAttribute(&cus, hipDeviceAttributeMultiprocessorCount, dev);
        if (hipFuncSetAttribute((const void*)fwd_kernel, hipFuncAttributeMaxDynamicSharedMemorySize, LDS_BYTES) != hipSuccess) { fprintf(stderr, "kernel_launch: hipFuncSetAttribute failed\n"); grid = -1; return; }
        if (hipOccupancyMaxActiveBlocksPerMultiprocessor(&per_cu, (const void*)fwd_kernel, NTHREADS, LDS_BYTES) != hipSuccess || per_cu < 1) { fprintf(stderr, "kernel_launch: occupancy query says %d\n", per_cu); per_cu = 1; }
        (void)hipGetLastError();
        grid = cus * 1;
    }
    if (grid < 0) return;
    (void)hipMemsetAsync((char*)d_ws + WS_CTL, 0, CTL_BYTES, stream);
    Args a{};
    for (int i = 0; i < 19; ++i) a.in[i] = (const float*)d_in[i];
    a.out = (float*)d_out; a.ws = (unsigned char*)d_ws;
#if MK_N_LAUNCHES == 1
    a.ph_lo = 0; a.ph_hi = 7;
    void* kargs[] = {&a};
    hipError_t e = hipLaunchCooperativeKernel((const void*)fwd_kernel, dim3(grid), dim3(NTHREADS), kargs, LDS_BYTES, stream);
    if (e != hipSuccess) fprintf(stderr, "kernel_launch: cooperative launch failed: %s (grid %d)\n", hipGetErrorString(e), grid);
#else
    for (int p = 0; p < 7; ++p) { a.ph_lo = p; a.ph_hi = p + 1; hipLaunchKernelGGL(fwd_kernel, dim3(grid), dim3(NTHREADS), LDS_BYTES, stream, a); }
#endif
}
```

```cpp
#include <hip/hip_runtime.h>
#include <hip/hip_cooperative_groups.h>
#include <cstdio>
#include <cstdint>
namespace cg = cooperative_groups;

#ifndef MK_N_LAUNCHES
#define MK_N_LAUNCHES 1
#endif
#ifndef SB_EARLY_EXIT
#define SB_EARLY_EXIT 1
#endif

#define LAS __attribute__((address_space(3)))
typedef unsigned short bf16_t;
typedef short bf16x8 __attribute__((ext_vector_type(8)));
typedef float f32x4 __attribute__((ext_vector_type(4)));
typedef float f32x16 __attribute__((ext_vector_type(16)));
typedef unsigned u32x4 __attribute__((ext_vector_type(4)));
typedef unsigned u32x2 __attribute__((ext_vector_type(2)));
typedef float f32x2_t __attribute__((ext_vector_type(2)));
typedef __bf16 bf16x2_t __attribute__((ext_vector_type(2)));

constexpr int SEQ = 8192, DM = 1024, MROWS = 2 * SEQ, NMETA = 16, DFF = 2816;
constexpr float EPS = 1e-6f;
constexpr float LOG2E = 1.4426950408889634f;
constexpr int NWAVES = 8, NTHREADS = 512;
constexpr int PROJ_LD = 4096 + 128;
constexpr int PC_SBQ = 0, PC_SBK = 1024, PC_DFQ = 2048, PC_DFK = 3072;

constexpr size_t MiB = 1u << 20;
constexpr size_t WS_CTL = 0, CTL_BYTES = 224 * 1024;
constexpr size_t CTL_QUEUE = 256;
constexpr size_t CTL_NK = 1024;
constexpr size_t CTL_PCNT = 4096;
constexpr size_t CTL_BAR = 64 * 1024;
constexpr size_t CTL_SS1 = 96 * 1024, CTL_SS2 = 160 * 1024;
constexpr size_t WS_W1T = 1 * MiB;
constexpr size_t WS_METAK = 17 * MiB;
constexpr size_t WS_METAV = WS_METAK + 640 * 1024;
constexpr size_t WS_XN = 18 * MiB;
constexpr size_t WS_WBR = 18 * MiB;
constexpr size_t WS_WOUT2 = 22 * MiB;
constexpr size_t WS_WFFN = 26 * MiB;
constexpr size_t WS_WDOWN = 38 * MiB;
constexpr size_t WS_PROJ = 50 * MiB;
constexpr size_t WS_H1B = 50 * MiB;
constexpr size_t WS_ACT = 82 * MiB;
constexpr size_t WS_GATES = 184 * MiB;
constexpr size_t WS_H1 = 184 * MiB;
constexpr size_t WS_END = 248 * MiB;

__device__ __forceinline__ unsigned cvtpk(float lo, float hi) { f32x2_t v = {lo, hi}; bf16x2_t b = __builtin_convertvector(v, bf16x2_t); return __builtin_bit_cast(unsigned, b); }
__device__ __forceinline__ float bf2f(unsigned short b) { return __builtin_bit_cast(float, (unsigned)b << 16); }
__device__ __forceinline__ float wave_sum(float v) {
#pragma unroll
    for (int o = 1; o < 64; o <<= 1) v += __shfl_xor(v, o);
    return v;
}
__device__ __forceinline__ void st16_wt(void* p, u32x4 v) { asm volatile("global_store_dwordx4 %0, %1, off sc1\n\ts_nop 1" :: "v"(p), "v"(v) : "memory"); }
__device__ __forceinline__ float fast_sigmoid(float x) { return __builtin_amdgcn_rcpf(1.0f + __builtin_amdgcn_exp2f(-x * LOG2E)); }

namespace pg8 {
constexpr int BM = 256, BK = 64, HALF = 128, HTB = HALF * BK * 2, STAGE_BYTES = 8 * HTB, NXCD = 8;
__host__ __device__ __forceinline__ int lds_byte(int r, int c) { const int st = (r >> 4) * 2 + (c >> 5), rr = r & 15, cc = c & 31, ob = rr * 64 + cc * 2; return st * 1024 + (ob ^ (((ob >> 9) & 1) << 5)); }
__host__ __device__ __forceinline__ void stage_rc(int b, int& R, int& C) { const int st = b / 1024, sb = b % 1024, swz = sb ^ (((sb >> 9) & 1) << 5); R = (st >> 1) * 16 + swz / 64; C = (st & 1) * 32 + (swz % 64) / 2; }
__host__ __device__ __forceinline__ int perm32(int rho) { const int n = rho >> 4, i = rho & 15; return 8 * (i >> 2) + 4 * n + (i & 3); }

struct Unit { int pm, pn, kind; const char* A; const char* B; };
__device__ __forceinline__ void tile_order(int wgid, int nM, int nN, int& pm, int& pn, const int WGM = 2) {
    const int nwg = nM * nN;
    { const int q = nwg / NXCD, r = nwg % NXCD, xcd = wgid % NXCD, off = wgid / NXCD; wgid = (xcd < r ? xcd * (q + 1) : r * (q + 1) + (xcd - r) * q) + off; }
    const int nig = WGM * nN, gid = wgid / nig, fm = gid * WGM, gsz = (nM - fm) < WGM ? (nM - fm) : WGM;
    pm = fm + ((wgid % nig) % gsz); pn = (wgid % nig) / gsz;
}
template <class Epi, class Sched, bool ALIGN_EPI>
__device__ __forceinline__ void gemm_phase(LAS unsigned char* lds, const int K, const int lda, const int ldb, const Sched& S, const Epi& E) {
    const int tid = threadIdx.x, wid = __builtin_amdgcn_readfirstlane(tid >> 6), lane = tid & 63, wr = wid >> 2, wc = wid & 3, fr = lane & 15, fq = lane >> 4;
    const int nt = K / BK;
    unsigned voffA[2], voffB[2];
#pragma unroll
    for (int i = 0; i < 2; ++i) { int R, C; stage_rc(tid * 16 + i * 8192, R, C); const int Rb = Epi::PERM ? ((R & ~31) + perm32(R & 31)) : R;
        voffA[i] = (unsigned)(R * lda + C) * 2u; voffB[i] = (unsigned)(Rb * ldb + C) * 2u; }
    const size_t kstep = (size_t)(BK * 2);
    const size_t hstepA = (size_t)HALF * lda * 2, hstepB = (size_t)HALF * ldb * 2;
    const unsigned ldsw = (unsigned)wid * 1024u;
    const int aoff = lds_byte(wr * 64 + fr, fq * 8), boff = lds_byte(wc * 32 + fr, fq * 8);
#define PG8_SA(b, h) (((b) * 2 + (h)) * HTB)
#define PG8_SB(b, h) ((4 + (b) * 2 + (h)) * HTB)
#define PG8_STAGE(bufoff, gbase, voff) do { _Pragma("unroll") for (int _i = 0; _i < 2; ++_i) \
        __builtin_amdgcn_global_load_lds((const unsigned*)((const char*)(gbase) + (voff)[_i]), (LAS unsigned*)(lds + (bufoff) + ldsw + _i * 8192), 16, 0, 0); } while (0)
#define PG8_LDA(dst, b, h) do { _Pragma("unroll") for (int m = 0; m < 4; ++m) _Pragma("unroll") for (int k = 0; k < 2; ++k) dst[m][k] = *(const LAS bf16x8*)(lds + PG8_SA(b, h) + aoff + m * 2048 + k * 1024); } while (0)
#define PG8_LDB(dst, b, h) do { _Pragma("unroll") for (int n = 0; n < 2; ++n) _Pragma("unroll") for (int k = 0; k < 2; ++k) dst[n][k] = *(const LAS bf16x8*)(lds + PG8_SB(b, h) + boff + n * 2048 + k * 1024); } while (0)
#define PG8_MMA(ai, bj, At, Bt) do { __builtin_amdgcn_s_setprio(1); _Pragma("unroll") for (int m = 0; m < 4; ++m) _Pragma("unroll") for (int n = 0; n < 2; ++n) _Pragma("unroll") for (int k = 0; k < 2; ++k) \
        acc[ai][bj][m][n] = __builtin_amdgcn_mfma_f32_16x16x32_bf16(Bt[n][k], At[m][k], acc[ai][bj][m][n], 0, 0, 0); __builtin_amdgcn_s_setprio(0); } while (0)
#define PG8_WAIT_V(n) asm volatile("s_waitcnt vmcnt(" #n ")" ::: "memory")
#define PG8_WAIT_L(n) asm volatile("s_waitcnt lgkmcnt(" #n ")" ::: "memory")
#define PG8_BAR __builtin_amdgcn_s_barrier()
#define PG8_SCHED __builtin_amdgcn_sched_barrier(0)
    Unit cur, nxt; int ui = 0;
    if (!S.next(0, cur)) return;
    f32x4 acc[2][2][4][2];
#pragma unroll
    for (int a = 0; a < 2; ++a)
#pragma unroll
        for (int b = 0; b < 2; ++b)
#pragma unroll
            for (int m = 0; m < 4; ++m)
#pragma unroll
                for (int n = 0; n < 2; ++n) acc[a][b][m][n] = (f32x4){0.f, 0.f, 0.f, 0.f};
    bf16x8 At[4][2], B0[2][2], B1[2][2];
    const char* cA = cur.A; const char* cB = cur.B;
    PG8_STAGE(PG8_SB(0, 0), cB, voffB); PG8_STAGE(PG8_SB(0, 1), cB + hstepB, voffB); PG8_STAGE(PG8_SA(0, 0), cA, voffA); PG8_STAGE(PG8_SA(0, 1), cA + hstepA, voffA);
    if (wr == 1) PG8_BAR;
    PG8_WAIT_V(2); PG8_BAR;
    PG8_STAGE(PG8_SB(1, 0), cB + kstep, voffB); PG8_STAGE(PG8_SA(1, 0), cA + kstep, voffA); PG8_STAGE(PG8_SB(1, 1), cB + hstepB + kstep, voffB);
    PG8_WAIT_V(6); PG8_BAR;
    for (;;) {
        const bool has_next = S.next(ui + 1, nxt);
        const char* nA = has_next ? nxt.A : cA; const char* nB = has_next ? nxt.B : cB;
        for (int t = 0; t < nt; t += 2) {
            const bool last = (t == nt - 2);
            const char* a1 = cA + (size_t)(t + 1) * kstep;
            const char* a2 = last ? nA : cA + (size_t)(t + 2) * kstep; const char* b2 = last ? nB : cB + (size_t)(t + 2) * kstep;
            const char* a3 = a2 + kstep; const char* b3 = b2 + kstep;
            PG8_LDB(B0, 0, 0); PG8_LDB(B1, 0, 1); PG8_SCHED; PG8_LDA(At, 0, 0); PG8_STAGE(PG8_SA(1, 1), a1 + hstepA, voffA);
            PG8_WAIT_V(8); PG8_WAIT_L(0); PG8_BAR; PG8_MMA(0, 0, At, B0); PG8_MMA(0, 1, At, B1); PG8_BAR; PG8_SCHED;
            PG8_LDA(At, 0, 1); PG8_STAGE(PG8_SB(0, 0), b2, voffB); PG8_STAGE(PG8_SB(0, 1), b2 + hstepB, voffB); PG8_STAGE(PG8_SA(0, 0), a2, voffA);
            PG8_WAIT_V(8); PG8_WAIT_L(0); PG8_BAR; PG8_MMA(1, 0, At, B0); PG8_MMA(1, 1, At, B1); PG8_BAR; PG8_SCHED;
            PG8_LDB(B0, 1, 0); PG8_LDB(B1, 1, 1); PG8_SCHED; PG8_LDA(At, 1, 0); PG8_STAGE(PG8_SA(0, 1), a2 + hstepA, voffA);
            PG8_WAIT_V(8); PG8_WAIT_L(0); PG8_BAR; PG8_MMA(0, 0, At, B0); PG8_MMA(0, 1, At, B1); PG8_BAR; PG8_SCHED;
            PG8_LDA(At, 1, 1); PG8_STAGE(PG8_SB(1, 0), b3, voffB); PG8_STAGE(PG8_SB(1, 1), b3 + hstepB, voffB); PG8_STAGE(PG8_SA(1, 0), a3, voffA);
            PG8_WAIT_V(8); PG8_WAIT_L(0); PG8_BAR; PG8_MMA(1, 0, At, B0); PG8_MMA(1, 1, At, B1); PG8_BAR; PG8_SCHED;
        }
        if constexpr (ALIGN_EPI) { if (wr == 0) PG8_BAR; }
        E(acc, cur, wr, wc, fr, fq);
        if (!has_next) break;
#pragma unroll
        for (int a = 0; a < 2; ++a)
#pragma unroll
            for (int b = 0; b < 2; ++b)
#pragma unroll
                for (int m = 0; m < 4; ++m)
#pragma unroll
                    for (int n = 0; n < 2; ++n) acc[a][b][m][n] = (f32x4){0.f, 0.f, 0.f, 0.f};
        cur = nxt; cA = nA; cB = nB; ++ui;
        if constexpr (ALIGN_EPI) { if (wr == 1) PG8_BAR; }
    }
    PG8_WAIT_V(0);
    if constexpr (!ALIGN_EPI) { if (wr == 0) PG8_BAR; }
    PG8_BAR;
#undef PG8_SA
#undef PG8_SB
#undef PG8_STAGE
#undef PG8_LDA
#undef PG8_LDB
#undef PG8_MMA
#undef PG8_WAIT_V
#undef PG8_WAIT_L
#undef PG8_BAR
#undef PG8_SCHED
}
}

#ifndef WGM_P1A
#define WGM_P1A 3
#endif
#ifndef WGM_P1B
#define WGM_P1B 8
#endif
#ifndef WGM_P5
#define WGM_P5 2
#endif
using pg8::Unit;
struct SchedP1 {
    const char* XN; const char* W1T; int G, c;
    __device__ __forceinline__ bool next(int i, Unit& u) const {
        const int L = i * G + c; if (L >= 2048) return false;
        if (L < 1536) { pg8::tile_order(L, 64, 24, u.pm, u.pn, WGM_P1A); u.kind = (u.pn < 16) ? 0 : 1; u.A = XN + (size_t)u.pm * 256 * 1024 * 2; u.B = W1T + (size_t)u.pn * 256 * 1024 * 2; }
        else { pg8::tile_order(L - 1536, 8, 64, u.pm, u.pn, WGM_P1B); u.kind = 2; u.A = W1T + (size_t)(6144 + u.pm * 256) * 1024 * 2; u.B = XN + (size_t)u.pn * 256 * 1024 * 2; }
        return true;
    }
};
struct EpiP1 {
    static constexpr bool PERM = true;
    bf16_t* PROJ; bf16_t* GATES; bf16_t* VT; const float* bgate; unsigned* nk;
    __device__ __forceinline__ void operator()(const f32x4 (&acc)[2][2][4][2], const Unit& u, int wr, int wc, int fr, int fq) const {
        if (u.kind == 0 && u.pn >= 12) {
#pragma unroll
            for (int bj = 0; bj < 2; ++bj) { float mxv = 0.f;
#pragma unroll
                for (int ai = 0; ai < 2; ++ai)
#pragma unroll
                    for (int m = 0; m < 4; ++m) { const f32x4 a = acc[ai][bj][m][0], bq = acc[ai][bj][m][1];
                        float q = (a[0] * a[0] + a[1] * a[1]) + (a[2] * a[2] + a[3] * a[3]) + (bq[0] * bq[0] + bq[1] * bq[1]) + (bq[2] * bq[2] + bq[3] * bq[3]);
                        q += __shfl_xor(q, 16); q += __shfl_xor(q, 32); mxv = __builtin_fmaxf(mxv, q); }
                mxv = __builtin_fmaxf(mxv, __shfl_xor(mxv, 1)); mxv = __builtin_fmaxf(mxv, __shfl_xor(mxv, 2)); mxv = __builtin_fmaxf(mxv, __shfl_xor(mxv, 4)); mxv = __builtin_fmaxf(mxv, __shfl_xor(mxv, 8));
                if (fr == 0 && fq == 0) atomicMax(nk + (u.pm >= 32 ? 32 : 0) + ((u.pn - 12) * 256 + bj * 128 + wc * 32) / 32, __float_as_uint(mxv)); }
        }
        bf16_t* base; int ldc, colt; const float* bias = nullptr;
        if (u.kind == 0) { base = PROJ; ldc = PROJ_LD; colt = u.pn * 256; }
        else if (u.kind == 1) { base = GATES; ldc = 2048; colt = (u.pn - 16) * 256; bias = bgate + colt; }
        else { base = VT; ldc = MROWS; colt = u.pn * 256; }
        const int row0 = u.pm * 256 + wr * 64 + fr, col0 = colt + wc * 32 + 8 * fq;
        f32x4 bv[2][2];
#pragma unroll
        for (int bj = 0; bj < 2; ++bj)
#pragma unroll
            for (int n = 0; n < 2; ++n) bv[bj][n] = bias ? *(const f32x4*)(bias + wc * 32 + 8 * fq + bj * 128 + 4 * n) : (f32x4){0.f, 0.f, 0.f, 0.f};
#pragma unroll
        for (int ai = 0; ai < 2; ++ai)
#pragma unroll
            for (int m = 0; m < 4; ++m) { bf16_t* rowp = base + (size_t)(row0 + ai * 128 + m * 16) * ldc + col0;
#pragma unroll
                for (int bj = 0; bj < 2; ++bj) { f32x4 v0 = acc[ai][bj][m][0] + bv[bj][0], v1 = acc[ai][bj][m][1] + bv[bj][1];
                    if (u.kind == 1) {
#pragma unroll
                        for (int i = 0; i < 4; ++i) { v0[i] = fast_sigmoid(v0[i]); v1[i] = fast_sigmoid(v1[i]); } }
                    u32x4 w; w.x = cvtpk(v0[0], v0[1]); w.y = cvtpk(v0[2], v0[3]); w.z = cvtpk(v1[0], v1[1]); w.w = cvtpk(v1[2], v1[3]);
                    st16_wt(rowp + bj * 128, w); } }
    }
};
struct SchedP3 {
    const char* PROJ; const char* WBR; int G, c;
    __device__ __forceinline__ bool next(int i, Unit& u) const {
        const int pair = (i >> 1) * G + c; if (pair >= 256) return false;
        pg8::tile_order(pair, 64, 4, u.pm, u.pn); u.kind = i & 1;
        u.A = PROJ + ((size_t)u.pm * 256 * PROJ_LD + (u.kind ? PC_DFQ : PC_SBQ)) * 2; u.B = WBR + (size_t)(u.kind * 1024 + u.pn * 256) * 1024 * 2; return true;
    }
};
struct EpiP3 {
    static constexpr bool PERM = true;
    const bf16_t* GATES; bf16_t* Y;
    __device__ __forceinline__ void operator()(const f32x4 (&acc)[2][2][4][2], const Unit& u, int wr, int wc, int fr, int fq) const {
        const int row0 = u.pm * 256 + wr * 64 + fr, col0 = u.pn * 256 + wc * 32 + 8 * fq;
#pragma unroll
        for (int ai = 0; ai < 2; ++ai) {
            u32x4 gv[4][2], pv[4][2];
#pragma unroll
            for (int m = 0; m < 4; ++m) { const size_t row = (size_t)(row0 + ai * 128 + m * 16);
#pragma unroll
                for (int bj = 0; bj < 2; ++bj) { gv[m][bj] = *(const u32x4*)(GATES + row * 2048 + u.kind * 1024 + col0 + bj * 128);
                    if (u.kind) pv[m][bj] = *(const u32x4*)(Y + row * 1024 + col0 + bj * 128); } }
            __builtin_amdgcn_sched_barrier(0);
#pragma unroll
            for (int m = 0; m < 4; ++m) { const size_t row = (size_t)(row0 + ai * 128 + m * 16);
#pragma unroll
                for (int bj = 0; bj < 2; ++bj) { const u32x4 g = gv[m][bj];
                    bf16_t* yp = Y + row * 1024 + col0 + bj * 128;
                    const f32x4 v0 = acc[ai][bj][m][0], v1 = acc[ai][bj][m][1];
                    float o[8] = {v0[0] * bf2f(g.x & 0xffff), v0[1] * bf2f(g.x >> 16), v0[2] * bf2f(g.y & 0xffff), v0[3] * bf2f(g.y >> 16),
                                  v1[0] * bf2f(g.z & 0xffff), v1[1] * bf2f(g.z >> 16), v1[2] * bf2f(g.w & 0xffff), v1[3] * bf2f(g.w >> 16)};
                    if (u.kind) { const u32x4 p = pv[m][bj];
                        o[0] += bf2f(p.x & 0xffff); o[1] += bf2f(p.x >> 16); o[2] += bf2f(p.y & 0xffff); o[3] += bf2f(p.y >> 16);
                        o[4] += bf2f(p.z & 0xffff); o[5] += bf2f(p.z >> 16); o[6] += bf2f(p.w & 0xffff); o[7] += bf2f(p.w >> 16); }
                    u32x4 w; w.x = cvtpk(o[0], o[1]); w.y = cvtpk(o[2], o[3]); w.z = cvtpk(o[4], o[5]); w.w = cvtpk(o[6], o[7]);
                    *(u32x4*)yp = w; } }
            __builtin_amdgcn_sched_barrier(0);
        }
    }
};
struct SchedN1024 {
    const char* A; const char* B; size_t lda_b, ldb_b; int G, c;
    __device__ __forceinline__ bool next(int i, Unit& u) const {
        const int L = i * G + c; if (L >= 256) return false;
        pg8::tile_order(L, 64, 4, u.pm, u.pn); u.kind = 0; u.A = A + (size_t)u.pm * 256 * lda_b; u.B = B + (size_t)u.pn * 256 * ldb_b; return true;
    }
};
struct EpiRes {
    static constexpr bool PERM = false;
    const float* base; float* out; bf16_t* outb; float* ss;
    __device__ __forceinline__ void operator()(const f32x4 (&acc)[2][2][4][2], const Unit& u, int wr, int wc, int fr, int fq) const {
        const int col0 = u.pn * 256 + wc * 32 + 4 * fq;
#pragma unroll
        for (int ai = 0; ai < 2; ++ai) {
            f32x4 pre[4][2][2];
#pragma unroll
            for (int m = 0; m < 4; ++m) { const size_t off = (size_t)(u.pm * 256 + ai * 128 + wr * 64 + m * 16 + fr) * 1024 + col0;
#pragma unroll
                for (int bj = 0; bj < 2; ++bj)
#pragma unroll
                    for (int n = 0; n < 2; ++n) pre[m][bj][n] = *(const f32x4*)(base + off + bj * 128 + n * 16); }
            __builtin_amdgcn_sched_barrier(0);
#pragma unroll
            for (int m = 0; m < 4; ++m) { const int row = u.pm * 256 + ai * 128 + wr * 64 + m * 16 + fr; const size_t off = (size_t)row * 1024 + col0; float q = 0.f;
#pragma unroll
                for (int bj = 0; bj < 2; ++bj)
#pragma unroll
                    for (int n = 0; n < 2; ++n) { const f32x4 o = pre[m][bj][n] + acc[ai][bj][m][n];
                        if (out) *(f32x4*)(out + off + bj * 128 + n * 16) = o;
                        q += (o[0] * o[0] + o[1] * o[1]) + (o[2] * o[2] + o[3] * o[3]);
                        if (outb) { u32x2 w; w.x = cvtpk(o[0], o[1]); w.y = cvtpk(o[2], o[3]); *(u32x2*)(outb + off + bj * 128 + n * 16) = w; } }
                q += __shfl_xor(q, 16); q += __shfl_xor(q, 32);
                if (fq == 0) atomicAdd(ss + row, q); }
            __builtin_amdgcn_sched_barrier(0);
        }
    }
};
struct EpiFinal {
    static constexpr bool PERM = false;
    const bf16_t* base; float* out; float* ss; unsigned* cnt; const float* g;
    __device__ __forceinline__ void operator()(f32x4 (&acc)[2][2][4][2], const Unit& u, int wr, int wc, int fr, int fq) const {
        const int col0 = u.pn * 256 + wc * 32 + 4 * fq;
        u32x2 hbv[2][4][2][2];
#pragma unroll
        for (int ai = 0; ai < 2; ++ai)
#pragma unroll
            for (int m = 0; m < 4; ++m) { const size_t off = (size_t)(u.pm * 256 + ai * 128 + wr * 64 + m * 16 + fr) * 1024 + col0;
#pragma unroll
                for (int bj = 0; bj < 2; ++bj)
#pragma unroll
                    for (int n = 0; n < 2; ++n) hbv[ai][m][bj][n] = *(const u32x2*)(base + off + bj * 128 + n * 16); }
        __builtin_amdgcn_sched_barrier(0);
#pragma unroll
        for (int ai = 0; ai < 2; ++ai)
#pragma unroll
            for (int m = 0; m < 4; ++m) { const int row = u.pm * 256 + ai * 128 + wr * 64 + m * 16 + fr; float q = 0.f;
#pragma unroll
                for (int bj = 0; bj < 2; ++bj)
#pragma unroll
                    for (int n = 0; n < 2; ++n) { const u32x2 hb = hbv[ai][m][bj][n];
                        const f32x4 o = (f32x4){bf2f(hb.x & 0xffff), bf2f(hb.x >> 16), bf2f(hb.y & 0xffff), bf2f(hb.y >> 16)} + acc[ai][bj][m][n]; acc[ai][bj][m][n] = o;
                        q += (o[0] * o[0] + o[1] * o[1]) + (o[2] * o[2] + o[3] * o[3]); }
                q += __shfl_xor(q, 16); q += __shfl_xor(q, 32);
                if (fq == 0) atomicAdd(ss + row, q); }
        asm volatile("s_waitcnt vmcnt(0)" ::: "memory");
        unsigned* pc = cnt + 64 * u.pm;
        if (fr == 0 && fq == 0) __hip_atomic_fetch_add(pc, 1u, __ATOMIC_RELAXED, __HIP_MEMORY_SCOPE_AGENT);
        {   unsigned spins = 0;
            while ((unsigned)__builtin_amdgcn_readfirstlane(__hip_atomic_load(pc, __ATOMIC_RELAXED, __HIP_MEMORY_SCOPE_AGENT)) < 32u && ++spins < (1u << 20)) __builtin_amdgcn_s_sleep(2); }
        asm volatile("" ::: "memory");
        f32x4 gv[2][2];
#pragma unroll
        for (int bj = 0; bj < 2; ++bj)
#pragma unroll
            for (int n = 0; n < 2; ++n) gv[bj][n] = *(const f32x4*)(g + col0 + bj * 128 + n * 16);
#pragma unroll
        for (int ai = 0; ai < 2; ++ai)
#pragma unroll
            for (int m = 0; m < 4; ++m) { const int row = u.pm * 256 + ai * 128 + wr * 64 + m * 16 + fr; const size_t off = (size_t)row * 1024 + col0;
                const float tot = __hip_atomic_load(ss + row, __ATOMIC_RELAXED, __HIP_MEMORY_SCOPE_AGENT);
                const float rstd = __builtin_amdgcn_rsqf(tot * (1.0f / DM) + EPS);
#pragma unroll
                for (int bj = 0; bj < 2; ++bj)
#pragma unroll
                    for (int n = 0; n < 2; ++n) *(f32x4*)(out + off + bj * 128 + n * 16) = acc[ai][bj][m][n] * rstd * gv[bj][n]; }
    }
};
struct SchedP5 {
    const char* A; const char* B; int G, c;
    __device__ __forceinline__ bool next(int i, Unit& u) const {
        const int L = i * G + c; if (L >= 64 * 22) return false;
        pg8::tile_order(L, 64, 22, u.pm, u.pn, WGM_P5); u.kind = 0; u.A = A + (size_t)u.pm * 256 * 1024 * 2; u.B = B + (size_t)u.pn * 256 * 1024 * 2; return true;
    }
};
struct EpiP5 {
    static constexpr bool PERM = true;
    const float* ss; bf16_t* ACT;
    __device__ __forceinline__ void operator()(const f32x4 (&acc)[2][2][4][2], const Unit& u, int wr, int wc, int fr, int fq) const {
        const int col0 = u.pn * 128 + wc * 32 + 8 * fq;
        float ssv[2][4];
#pragma unroll
        for (int ai = 0; ai < 2; ++ai)
#pragma unroll
            for (int m = 0; m < 4; ++m) ssv[ai][m] = ss[u.pm * 256 + ai * 128 + wr * 64 + m * 16 + fr];
        __builtin_amdgcn_sched_barrier(0);
#pragma unroll
        for (int ai = 0; ai < 2; ++ai)
#pragma unroll
            for (int m = 0; m < 4; ++m) { const int row = u.pm * 256 + ai * 128 + wr * 64 + m * 16 + fr; const float r = __builtin_amdgcn_rsqf(ssv[ai][m] * (1.0f / DM) + EPS);
                float o[8];
#pragma unroll
                for (int n = 0; n < 2; ++n)
#pragma unroll
                    for (int i = 0; i < 4; ++i) { const float g = acc[ai][0][m][n][i] * r, up = acc[ai][1][m][n][i] * r; o[4 * n + i] = g * fast_sigmoid(g) * up; }
                u32x4 w; w.x = cvtpk(o[0], o[1]); w.y = cvtpk(o[2], o[3]); w.z = cvtpk(o[4], o[5]); w.w = cvtpk(o[6], o[7]);
                *(u32x4*)(ACT + (size_t)row * DFF + col0) = w; }
    }
};

namespace att {
constexpr int KBYTES = 16384, VBYTES = 16384, TILE_BYTES = KBYTES + VBYTES;
constexpr int NBUF = 3, FLAG_OFF = NBUF * TILE_BYTES;
constexpr int Q_OFF = FLAG_OFF + 64;
static_assert(Q_OFF + 8 * 4096 <= 147456 - 64, "attention LDS map");
struct TileSrc { const bf16_t* k; const bf16_t* v; unsigned vp; };

__device__ __forceinline__ void tile_dma(const TileSrc& s, LAS unsigned char* buf, int wid, int lane) {
#pragma unroll
    for (int i = 0; i < 2; ++i) {
        const int piece = wid * 2 + i;
        { const int row = piece * 4 + (lane >> 4), cc = (lane & 15) ^ (row & 15); const unsigned off = (unsigned)(row * PROJ_LD + cc * 8);
          __builtin_amdgcn_global_load_lds((const unsigned*)(s.k + off), (LAS unsigned*)(buf + piece * 1024), 16, 0, 0); }
        { const int d = piece * 8 + (lane >> 3), cc = (lane & 7) ^ ((d >> 1) & 7); const unsigned off = (unsigned)d * s.vp + (unsigned)(cc * 8);
          __builtin_amdgcn_global_load_lds((const unsigned*)(s.v + off), (LAS unsigned*)(buf + KBYTES + piece * 1024), 16, 0, 0); }
    }
}
#define ATT_DMA_WAIT() asm volatile("s_waitcnt vmcnt(0)" ::: "memory")
#define ATT_WAIT_RING(newest_in_flight) do { if (newest_in_flight) asm volatile("s_waitcnt vmcnt(4)" ::: "memory"); else asm volatile("s_waitcnt vmcnt(0)" ::: "memory"); } while (0)
#define ATT_BAR() do { asm volatile("s_waitcnt lgkmcnt(0)" ::: "memory"); __builtin_amdgcn_s_barrier(); asm volatile("" ::: "memory"); } while (0)
__device__ __forceinline__ int pi32(int r) { return (r & 0x13) | ((r & 4) << 1) | ((r & 8) >> 1); }

struct Ctx {
    const bf16_t* PROJ; bf16_t* PROJW; const bf16_t* VT; const bf16_t* METAK; const bf16_t* METAV;
    const float* subln; const float* nk; unsigned* queue; float lam;
    LAS unsigned char* lds; int tid, lane, wid, r, h;
};
__device__ __forceinline__ TileSrc tile_src(const Ctx& c, int b, int j, int kcol, int vrow) {
    TileSrc s;
    if (j >= 0) { s.k = c.PROJ + ((size_t)(b * SEQ + 64 * j)) * PROJ_LD + kcol; s.v = c.VT + (size_t)vrow * MROWS + b * SEQ + 64 * j; s.vp = MROWS; }
    else { s.k = c.METAK + kcol; s.v = c.METAV + (size_t)vrow * 64; s.vp = 64; }
    return s;
}
__device__ __forceinline__ int k_addr(int sub, int r, int chunk) { const int row = 32 * sub + pi32(r); return row * 256 + ((chunk ^ (row & 15)) << 4); }
__device__ __forceinline__ int v_addr(int d, int chunk) { return KBYTES + d * 128 + ((chunk ^ ((d >> 1) & 7)) << 4); }

__device__ __forceinline__ void sb_unit(const Ctx& c, int b, int hd, int qb) {
    int lane = (int)__builtin_amdgcn_mbcnt_hi(~0u, __builtin_amdgcn_mbcnt_lo(~0u, 0u)); asm volatile("" : "+v"(lane));
    const int wid = c.wid, tid = wid * 64 + lane, r = lane & 31, h = lane >> 5;
    const int tq = 256 * qb + 32 * wid + r;
    const size_t qrow = (size_t)(b * SEQ + tq) * PROJ_LD + PC_SBQ + hd * 128;
    bf16x8 qf[8];
#pragma unroll
    for (int ks = 0; ks < 8; ++ks) qf[ks] = *(const bf16x8*)(c.PROJ + qrow + 16 * ks + 8 * h);
    f32x16 o[4];
#pragma unroll
    for (int dt = 0; dt < 4; ++dt) o[dt] = f32x16{};
    float C = 1.0f;
    const int jmax = 4 * qb + 3, NT = jmax + 2;
    const int kcolx = PC_SBK + hd * 128, vrow = hd * 128;
    LAS unsigned* flags = (LAS unsigned*)(c.lds + FLAG_OFF);
    if (tid == 0) { flags[0] = 0u; flags[1] = 0u; flags[2] = 0u; }
    {   const TileSrc s0 = tile_src(c, b, jmax, kcolx, vrow); tile_dma(s0, c.lds, wid, lane);
        const TileSrc s1 = tile_src(c, b, jmax - 1, kcolx, vrow); tile_dma(s1, c.lds + TILE_BYTES, wid, lane); }
    ATT_WAIT_RING(true); ATT_BAR();
    const int mydiag = 4 * qb + (wid >> 1);
    bool finished = false;
    int bcur = 0;
    for (int t = 0; t < NT; ++t) {
        const int j = (t <= jmax) ? jmax - t : -1;
        const LAS unsigned char* cur = c.lds + bcur * TILE_BYTES;
        const bool more = (t + 2 < NT);
        if (more) { const int jn = (t + 2 <= jmax) ? jmax - (t + 2) : -1; const int bn = (bcur >= 1) ? bcur - 1 : bcur + 2; const TileSrc s = tile_src(c, b, jn, kcolx, vrow); tile_dma(s, c.lds + bn * TILE_BYTES, wid, lane); }
        bcur = (bcur == 2) ? 0 : bcur + 1;
        const bool wave_active = (j < 0) || (j <= mydiag);
        if (wave_active && !finished) {
            const int lim = (j >= 0) ? (tq - 64 * j) : NMETA;
#pragma unroll 1
            for (int sub = 1; sub >= 0; --sub) {
                f32x16 s = f32x16{};
                bf16x8 ka[8], va[8];
#pragma unroll
                for (int ks = 0; ks < 8; ++ks) ka[ks] = *(const LAS bf16x8*)(cur + k_addr(sub, r, 2 * ks + h));
                __builtin_amdgcn_sched_barrier(0);
#pragma unroll
                for (int ks = 0; ks < 8; ++ks) s = __builtin_amdgcn_mfma_f32_32x32x16_bf16(ka[ks], qf[ks], s, 0, 0, 0);
                __builtin_amdgcn_sched_barrier(0);
                float av[16], fv[16];
#pragma unroll
                for (int reg = 0; reg < 16; ++reg) {
                    const int kap = 32 * sub + 16 * (reg >> 3) + 8 * h + (reg & 7);
                    const float z = __builtin_fminf(__builtin_fmaxf(s[reg], -115.f), 115.f);
                    const float e = __builtin_amdgcn_exp2f(-z); const float beta = __builtin_amdgcn_rcpf(1.0f + e); const float f = e * beta;
                    const bool valid = kap < lim; av[reg] = valid ? beta : 0.f; fv[reg] = valid ? f : 1.f;
                }
                float run = 1.f;
#pragma unroll
                for (int reg = 15; reg >= 8; --reg) { av[reg] *= run; run *= fv[reg]; }
                const float GU = run; run = 1.f;
#pragma unroll
                for (int reg = 7; reg >= 0; --reg) { av[reg] *= run; run *= fv[reg]; }
                const float GL = run;
                const float GUo = __shfl_xor(GU, 32), GLo = __shfl_xor(GL, 32);
                const float pU = GU * GUo, pL = GL * GLo;
                const float preU = h ? C : C * GUo, preL = h ? C * pU : (C * pU) * GLo;
                C = C * (pU * pL);
                u32x4 pf0, pf1;
                pf0.x = cvtpk(av[0] * preL, av[1] * preL); pf0.y = cvtpk(av[2] * preL, av[3] * preL); pf0.z = cvtpk(av[4] * preL, av[5] * preL); pf0.w = cvtpk(av[6] * preL, av[7] * preL);
                pf1.x = cvtpk(av[8] * preU, av[9] * preU); pf1.y = cvtpk(av[10] * preU, av[11] * preU); pf1.z = cvtpk(av[12] * preU, av[13] * preU); pf1.w = cvtpk(av[14] * preU, av[15] * preU);
                const bf16x8 p0 = __builtin_bit_cast(bf16x8, pf0), p1 = __builtin_bit_cast(bf16x8, pf1);
                __builtin_amdgcn_sched_barrier(0);
#pragma unroll
                for (int dt = 0; dt < 4; ++dt) { va[2 * dt] = *(const LAS bf16x8*)(cur + v_addr(32 * dt + r, 4 * sub + h)); va[2 * dt + 1] = *(const LAS bf16x8*)(cur + v_addr(32 * dt + r, 4 * sub + 2 + h)); }
                __builtin_amdgcn_sched_barrier(0);
#pragma unroll
                for (int dt = 0; dt < 4; ++dt) {
                    o[dt] = __builtin_amdgcn_mfma_f32_32x32x16_bf16(va[2 * dt], p0, o[dt], 0, 0, 0);
                    o[dt] = __builtin_amdgcn_mfma_f32_32x32x16_bf16(va[2 * dt + 1], p1, o[dt], 0, 0, 0);
                }
                __builtin_amdgcn_sched_barrier(0);
            }
            finished = __all(C < 1e-20f);
        }
        const int fw = t % 3;
        if (!finished && lane == 0) flags[fw] = 1u;
        ATT_WAIT_RING(more); ATT_BAR();
        const unsigned any_live = flags[fw];
        if (tid == 0) flags[(fw + 2) % 3] = 0u;
        if (SB_EARLY_EXIT && !any_live) break;
    }
    ATT_DMA_WAIT(); ATT_BAR();
    unsigned nxt = 0u; if (tid == 0) nxt = atomicAdd(c.queue, 1u);
    bf16_t* orow = c.PROJW + qrow;
#pragma unroll
    for (int dt = 0; dt < 4; ++dt)
#pragma unroll
        for (int g = 0; g < 4; ++g) { u32x2 w; w.x = cvtpk(o[dt][4 * g], o[dt][4 * g + 1]); w.y = cvtpk(o[dt][4 * g + 2], o[dt][4 * g + 3]); *(u32x2*)(orow + 32 * dt + 8 * g + 4 * h) = w; }
    if (tid == 0) flags[4] = nxt;
    ATT_BAR();
}

constexpr float DF_THR = 80.0f;
__device__ __forceinline__ float half_max(float v) { const auto rr = __builtin_amdgcn_permlane32_swap(__float_as_uint(v), __float_as_uint(v), false, false); return __builtin_fmaxf(__uint_as_float(rr[0]), __uint_as_float(rr[1])); }
__device__ __forceinline__ float half_sum(float v) { const auto rr = __builtin_amdgcn_permlane32_swap(__float_as_uint(v), __float_as_uint(v), false, false); return __uint_as_float(rr[0]) + __uint_as_float(rr[1]); }
template <int MODE, bool META>
__device__ __forceinline__ void df_tile(const LAS unsigned char* cur, const int j, const int r, const int h, const int cm, const float tqf, const float sl2, const LAS unsigned char* qp,
                                        f32x16 (&o)[4], float& mref, float& lsum, float& mlow, const float ubfar, bool& safe) {
    const float tqh = tqf - (float)(8 * h);
    const float cinit = (MODE == 0) ? 0.f : (-sl2 * tqh - mref);
    f32x16 s1, s0;
#pragma unroll
    for (int reg = 0; reg < 16; ++reg) { s1[reg] = cinit; s0[reg] = cinit; }
    bf16x8 ka[4], qf[4];
#pragma unroll
    for (int ks = 0; ks < 4; ++ks) qf[ks] = *(const LAS bf16x8*)(qp + ks * 1024);
#pragma unroll
    for (int kh = 0; kh < 2; ++kh) {
#pragma unroll
        for (int ks = 2 * kh; ks < 2 * kh + 2; ++ks) { ka[2 * (ks & 1)] = *(const LAS bf16x8*)(cur + k_addr(1, r, 8 * cm + 2 * ks + h)); ka[2 * (ks & 1) + 1] = *(const LAS bf16x8*)(cur + k_addr(0, r, 8 * cm + 2 * ks + h)); }
        __builtin_amdgcn_sched_barrier(0);
        __builtin_amdgcn_s_setprio(1);
#pragma unroll
        for (int ks = 2 * kh; ks < 2 * kh + 2; ++ks) {
            s1 = __builtin_amdgcn_mfma_f32_32x32x16_bf16(ka[2 * (ks & 1)], qf[ks], s1, 0, 0, 0);
            s0 = __builtin_amdgcn_mfma_f32_32x32x16_bf16(ka[2 * (ks & 1) + 1], qf[ks], s0, 0, 0, 0);
        }
        __builtin_amdgcn_sched_barrier(0);
    }
    __builtin_amdgcn_s_setprio(0);
    __builtin_amdgcn_sched_barrier(0);
    if (MODE == 0) {
        float mx = -INFINITY;
#pragma unroll
        for (int reg = 0; reg < 16; ++reg) {
            const float kc = (float)(16 * (reg >> 3) + (reg & 7));
            const float v1 = __builtin_fmaf(-sl2, __builtin_fabsf(tqh - (kc + 32.f)), s1[reg]);
            const float v0 = __builtin_fmaf(-sl2, __builtin_fabsf(tqh - kc), s0[reg]);
            s1[reg] = v1; s0[reg] = v0; mx = __builtin_fmaxf(mx, __builtin_fmaxf(v1, v0));
        }
        mx = half_max(mx); mlow = mx;
        const float mc = __builtin_fmaxf(mx, ubfar - 8.0f);
        safe = __all(mc - mx <= 90.0f);
        mref = safe ? mc : mx;
#pragma unroll
        for (int reg = 0; reg < 16; ++reg) { s1[reg] -= mref; s0[reg] -= mref; }
    } else {
#pragma unroll
        for (int reg = 0; reg < 16; ++reg) {
            const float kc = (float)(16 * (reg >> 3) + (reg & 7));
            float v1 = __builtin_fmaf(sl2, kc + 32.f, s1[reg]);
            float v0 = __builtin_fmaf(sl2, kc, s0[reg]);
            s1[reg] = v1; s0[reg] = v0;
        }
        if (MODE == 2) {
            float mx = -INFINITY;
#pragma unroll
            for (int reg = 0; reg < 16; ++reg) mx = __builtin_fmaxf(mx, __builtin_fmaxf(s1[reg], s0[reg]));
            mx = half_max(mx);
            const float dl = __builtin_fmaxf(mx, 0.f), sc = __builtin_amdgcn_exp2f(-dl);
            mref += dl; lsum *= sc;
#pragma unroll
            for (int reg = 0; reg < 16; ++reg) { s1[reg] -= dl; s0[reg] -= dl; }
#pragma unroll
            for (int dt = 0; dt < 4; ++dt) o[dt] *= sc;
        }
    }
    float ps = 0.f;
    if (META) {
#pragma unroll
        for (int reg = 0; reg < 8; ++reg) { const float p0 = __builtin_amdgcn_exp2f(s0[reg]); s0[reg] = p0; ps += p0; }
        lsum += ps;
        u32x4 wm; wm.x = cvtpk(s0[0], s0[1]); wm.y = cvtpk(s0[2], s0[3]); wm.z = cvtpk(s0[4], s0[5]); wm.w = cvtpk(s0[6], s0[7]);
        const bf16x8 pm = __builtin_bit_cast(bf16x8, wm);
        bf16x8 vm[4];
#pragma unroll
        for (int dt = 0; dt < 4; ++dt) vm[dt] = *(const LAS bf16x8*)(cur + v_addr(32 * dt + r, 0 + h));
        __builtin_amdgcn_sched_barrier(0);
#pragma unroll
        for (int dt = 0; dt < 4; ++dt) o[dt] = __builtin_amdgcn_mfma_f32_32x32x16_bf16(vm[dt], pm, o[dt], 0, 0, 0);
        __builtin_amdgcn_sched_barrier(0);
        return;
    }
#pragma unroll
    for (int reg = 0; reg < 16; ++reg) { const float p1 = __builtin_amdgcn_exp2f(s1[reg]), p0 = __builtin_amdgcn_exp2f(s0[reg]); s1[reg] = p1; s0[reg] = p0; ps += p1 + p0; }
    lsum += ps;
    u32x4 w1a, w1b, w0a, w0b;
    w1a.x = cvtpk(s1[0], s1[1]); w1a.y = cvtpk(s1[2], s1[3]); w1a.z = cvtpk(s1[4], s1[5]); w1a.w = cvtpk(s1[6], s1[7]);
    w1b.x = cvtpk(s1[8], s1[9]); w1b.y = cvtpk(s1[10], s1[11]); w1b.z = cvtpk(s1[12], s1[13]); w1b.w = cvtpk(s1[14], s1[15]);
    w0a.x = cvtpk(s0[0], s0[1]); w0a.y = cvtpk(s0[2], s0[3]); w0a.z = cvtpk(s0[4], s0[5]); w0a.w = cvtpk(s0[6], s0[7]);
    w0b.x = cvtpk(s0[8], s0[9]); w0b.y = cvtpk(s0[10], s0[11]); w0b.z = cvtpk(s0[12], s0[13]); w0b.w = cvtpk(s0[14], s0[15]);
    const bf16x8 p1a = __builtin_bit_cast(bf16x8, w1a), p1b = __builtin_bit_cast(bf16x8, w1b), p0a = __builtin_bit_cast(bf16x8, w0a), p0b = __builtin_bit_cast(bf16x8, w0b);
#define DF_VLOAD(dst, dt) do { dst[0] = *(const LAS bf16x8*)(cur + v_addr(32 * (dt) + r, 4 + h)); dst[1] = *(const LAS bf16x8*)(cur + v_addr(32 * (dt) + r, 6 + h)); \
        dst[2] = *(const LAS bf16x8*)(cur + v_addr(32 * (dt) + r, 0 + h)); dst[3] = *(const LAS bf16x8*)(cur + v_addr(32 * (dt) + r, 2 + h)); } while (0)
#define DF_PV(src, dt) do { o[dt] = __builtin_amdgcn_mfma_f32_32x32x16_bf16(src[0], p1a, o[dt], 0, 0, 0); o[dt] = __builtin_amdgcn_mfma_f32_32x32x16_bf16(src[1], p1b, o[dt], 0, 0, 0); \
        o[dt] = __builtin_amdgcn_mfma_f32_32x32x16_bf16(src[2], p0a, o[dt], 0, 0, 0); o[dt] = __builtin_amdgcn_mfma_f32_32x32x16_bf16(src[3], p0b, o[dt], 0, 0, 0); } while (0)
    bf16x8 vA[4], vB[2];
    __builtin_amdgcn_sched_barrier(0);
    DF_VLOAD(vA, 0); __builtin_amdgcn_sched_barrier(0);
    __builtin_amdgcn_s_setprio(1);
#define DF_VLOAD2(dst, dt) do { dst[0] = *(const LAS bf16x8*)(cur + v_addr(32 * (dt) + r, 4 + h)); dst[1] = *(const LAS bf16x8*)(cur + v_addr(32 * (dt) + r, 6 + h)); } while (0)
#define DF_VLOAD2B(dst, dt) do { dst[2] = *(const LAS bf16x8*)(cur + v_addr(32 * (dt) + r, 0 + h)); dst[3] = *(const LAS bf16x8*)(cur + v_addr(32 * (dt) + r, 2 + h)); } while (0)
#define DF_STAGE(dt, last) do { DF_VLOAD2(vB, (dt) + 1 - (last)); __builtin_amdgcn_sched_barrier(0); DF_PV(vA, dt); __builtin_amdgcn_sched_barrier(0); \
        if (!(last)) { vA[0] = vB[0]; vA[1] = vB[1]; DF_VLOAD2B(vA, (dt) + 1); __builtin_amdgcn_sched_barrier(0); } } while (0)
    DF_STAGE(0, 0); DF_STAGE(1, 0); DF_STAGE(2, 0); DF_PV(vA, 3);
#undef DF_VLOAD2
#undef DF_VLOAD2B
#undef DF_STAGE
#undef DF_VLOAD
#undef DF_PV
    __builtin_amdgcn_s_setprio(0);
    __builtin_amdgcn_sched_barrier(0);
}

__device__ __forceinline__ void df_unit(const Ctx& c, int b, int hd, int qb) {
    int lane = (int)__builtin_amdgcn_mbcnt_hi(~0u, __builtin_amdgcn_mbcnt_lo(~0u, 0u)); asm volatile("" : "+v"(lane));
    const int wid = c.wid, tid = wid * 64 + lane, r = lane & 31, h = lane >> 5, rg = wid & 3, cm = wid >> 2;
    const int tq = 128 * qb + 32 * rg + r;
    const size_t qrow = (size_t)(b * SEQ + tq) * PROJ_LD + PC_DFQ + hd * 128;
    bf16x8 qf[4];
#pragma unroll
    for (int ks = 0; ks < 4; ++ks) qf[ks] = *(const bf16x8*)(c.PROJ + qrow + 64 * cm + 16 * ks + 8 * h);
    float qn2 = 0.f;
#pragma unroll
    for (int ks = 0; ks < 4; ++ks)
#pragma unroll
        for (int i = 0; i < 8; ++i) { const float f = bf2f((unsigned short)qf[ks][i]); qn2 += f * f; }
    qn2 = half_sum(qn2);
    LAS unsigned char* qp = c.lds + Q_OFF + wid * 4096 + lane * 16;
#pragma unroll
    for (int ks = 0; ks < 4; ++ks) *(LAS bf16x8*)(qp + ks * 1024) = qf[ks];
    const float kmax2 = c.nk[b * 32 + hd * 4 + cm * 2] + c.nk[b * 32 + hd * 4 + cm * 2 + 1];
    const float bound0 = __builtin_sqrtf(qn2 * kmax2) * 1.02f;
    f32x16 o[4];
#pragma unroll
    for (int dt = 0; dt < 4; ++dt) o[dt] = f32x16{};
    float mref = 0.f, lsum = 0.f, mlow = 0.f;
    const float sl2 = __builtin_amdgcn_exp2f(-(float)(hd + 1)) * LOG2E;
    const int jmax = 2 * qb + 1, NT = jmax + 2;
    const int kcolx = PC_DFK + hd * 128, vrow = 1024 + hd * 128;
    LAS unsigned* flags = (LAS unsigned*)(c.lds + FLAG_OFF);
    if (tid == 0) { flags[0] = 0u; flags[1] = 0u; flags[2] = 0u; }
    {   const TileSrc s0 = tile_src(c, b, jmax, kcolx, vrow); tile_dma(s0, c.lds, wid, lane);
        const TileSrc s1 = tile_src(c, b, jmax - 1, kcolx, vrow); tile_dma(s1, c.lds + TILE_BYTES, wid, lane); }
    ATT_WAIT_RING(true); ATT_BAR();
    const int mychunk = 2 * qb + (rg >> 1);
    int bcur = 0, t = 0; bool blockdone = false, safe = false;
#define DF_STEP_BEGIN() \
        const int j = (t <= jmax) ? jmax - t : -1; \
        const LAS unsigned char* cur = c.lds + bcur * TILE_BYTES; \
        const bool more = (t + 2 < NT); \
        if (more) { const int jn = (t + 2 <= jmax) ? jmax - (t + 2) : -1; const int bn = (bcur >= 1) ? bcur - 1 : bcur + 2; const TileSrc s = tile_src(c, b, jn, kcolx, vrow); tile_dma(s, c.lds + bn * TILE_BYTES, wid, lane); } \
        bcur = (bcur == 2) ? 0 : bcur + 1;
#define DF_STEP_END(live) do { const int fw = t % 3; if ((live) && lane == 0) flags[fw] = 1u; ATT_WAIT_RING(more); ATT_BAR(); \
        const unsigned any_live = flags[fw]; if (tid == 0) flags[(fw + 2) % 3] = 0u; if (!any_live) blockdone = true; } while (0)
#define DF_TQF() ((float)(j >= 0 ? tq - 64 * j : tq + NMETA))
    for (; t < NT && !blockdone && ((t <= jmax) ? jmax - t : -1) > mychunk; ++t) { DF_STEP_BEGIN(); (void)j; (void)cur; DF_STEP_END(true); }
    {
        DF_STEP_BEGIN();
        const float dfar = (float)(mychunk >= 1 ? tq - (64 * (mychunk - 1) + 63) : tq + 1);
        int l0 = lane; asm volatile("" : "+v"(l0));
        df_tile<0, false>(cur, j, l0 & 31, l0 >> 5, cm, DF_TQF(), sl2, qp, o, mref, lsum, mlow, bound0 - sl2 * dfar, safe);
        DF_STEP_END(true); ++t;
    }
    if (safe) {
        int l1 = lane; asm volatile("" : "+v"(l1)); const int r1 = l1 & 31, h1 = l1 >> 5;
        bool fin = false;
        for (; t <= jmax && !blockdone; ++t) {
            const float dmin = (float)(tq - (64 * (jmax - t) + 63));
            if (__all(bound0 - sl2 * dmin - mlow < -DF_THR)) { fin = true; break; }
            DF_STEP_BEGIN();
            df_tile<1, false>(cur, j, r1, h1, cm, DF_TQF(), sl2, qp, o, mref, lsum, mlow, 0.f, safe);
            DF_STEP_END(true);
        }
        if (!fin && !blockdone && t < NT && !__all(bound0 - sl2 * (float)(tq + 1) - mlow < -DF_THR)) {
            DF_STEP_BEGIN();
            df_tile<1, true>(cur, j, r1, h1, cm, DF_TQF(), sl2, qp, o, mref, lsum, mlow, 0.f, safe);
            DF_STEP_END(true); ++t;
        }
    } else {
        int l2 = lane; asm volatile("" : "+v"(l2)); const int r2 = l2 & 31, h2 = l2 >> 5;
        bool fin = false;
        for (; t <= jmax && !blockdone; ++t) {
            const float dmin = (float)(tq - (64 * (jmax - t) + 63));
            if (__all(bound0 - sl2 * dmin - mlow < -DF_THR)) { fin = true; break; }
            DF_STEP_BEGIN();
            df_tile<2, false>(cur, j, r2, h2, cm, DF_TQF(), sl2, qp, o, mref, lsum, mlow, 0.f, safe);
            DF_STEP_END(true);
        }
        if (!fin && !blockdone && t < NT && !__all(bound0 - sl2 * (float)(tq + 1) - mlow < -DF_THR)) {
            DF_STEP_BEGIN();
            df_tile<2, true>(cur, j, r2, h2, cm, DF_TQF(), sl2, qp, o, mref, lsum, mlow, 0.f, safe);
            DF_STEP_END(true); ++t;
        }
    }
    for (; t < NT && !blockdone; ++t) { DF_STEP_BEGIN(); (void)j; (void)cur; DF_STEP_END(false); }
#undef DF_STEP_BEGIN
#undef DF_STEP_END
#undef DF_TQF
    ATT_DMA_WAIT(); ATT_BAR();
    unsigned nxt = 0u; if (tid == 0) nxt = atomicAdd(c.queue, 1u);
    const float L = half_sum(lsum);
    const float inv = (cm == 0 ? 1.0f : c.lam) / L;
    LAS float* xch = (LAS float*)(c.lds + rg * 16384);
    if (cm == 1) {
#pragma unroll
        for (int dt = 0; dt < 4; ++dt)
#pragma unroll
            for (int reg = 0; reg < 16; ++reg) xch[(dt * 16 + reg) * 64 + lane] = o[dt][reg] * inv;
    }
    ATT_BAR();
    if (cm == 0) {
        float ss = 0.f;
#pragma unroll
        for (int dt = 0; dt < 4; ++dt)
#pragma unroll
            for (int reg = 0; reg < 16; ++reg) { const float v = o[dt][reg] * inv - xch[(dt * 16 + reg) * 64 + lane]; o[dt][reg] = v; ss += v * v; }
        ss = half_sum(ss);
        const float rs = __builtin_amdgcn_rsqf(ss * (1.0f / 128.0f) + EPS) * 0.8f;
        bf16_t* orow = c.PROJW + qrow;
#pragma unroll
        for (int dt = 0; dt < 4; ++dt)
#pragma unroll
            for (int g = 0; g < 4; ++g) { const int d0 = 32 * dt + 8 * g + 4 * h; const f32x4 gn = *(const f32x4*)(c.subln + d0);
                u32x2 w; w.x = cvtpk(o[dt][4 * g] * rs * gn[0], o[dt][4 * g + 1] * rs * gn[1]); w.y = cvtpk(o[dt][4 * g + 2] * rs * gn[2], o[dt][4 * g + 3] * rs * gn[3]);
                *(u32x2*)(orow + d0) = w; }
    }
    if (tid == 0) flags[4] = nxt;
    ATT_BAR();
}
}


#define XB_TMO      128
#define XB_XCNT(j)  (256  + 64 * (j))
#define XB_XSUB(j)  (1280 + 64 * (j))
#define XB_XGEN(j)  (2304 + 64 * (j))
#define XB_TOP      3328
#define XB_TOPGEN   3392
#define XCD_BAR_WORDS 3456
#define XB_SPIN_CAP (1u << 22)
__device__ __forceinline__ unsigned xb_ld(unsigned* p)              { return __hip_atomic_load(p, __ATOMIC_RELAXED, __HIP_MEMORY_SCOPE_AGENT); }
__device__ __forceinline__ unsigned xb_add(unsigned* p, unsigned v) { return __hip_atomic_fetch_add(p, v, __ATOMIC_RELAXED, __HIP_MEMORY_SCOPE_AGENT); }
__device__ __forceinline__ unsigned xb_xcc_id() { return (unsigned)__builtin_amdgcn_s_getreg((3 << 11) | 20) & 0xFu; }
#define XB_SPIN(cond, bar) do { unsigned _sp = 0; while (cond) { __builtin_amdgcn_s_sleep(1); \
    if ((++_sp & 255u) == 0u) { if (xb_ld(&(bar)[XB_TMO])) break; if (_sp > XB_SPIN_CAP) { atomicAdd(&(bar)[XB_TMO], 1u); break; } } } } while (0)
struct XcdBarrier { unsigned* bar; unsigned x; volatile LAS unsigned* st; };
__device__ __forceinline__ XcdBarrier xcd_barrier_post(unsigned* bar, volatile LAS unsigned* st) {
    XcdBarrier b; b.bar = bar; b.x = xb_xcc_id(); b.st = st;
    if (threadIdx.x == 0) (void)xb_add(&bar[XB_XCNT(b.x)], 1u);
    return b;
}
__device__ __forceinline__ void xcd_barrier_complete(unsigned* bar, unsigned x, unsigned& nloc, unsigned& nx) {
    const unsigned G = gridDim.x * gridDim.y * gridDim.z;
    unsigned sum, cnt, mine, sp = 0u;
    for (;;) {
        sum = 0u; cnt = 0u; mine = 0u;
#pragma unroll
        for (unsigned j = 0; j < 16; ++j) { const unsigned c = xb_ld(&bar[XB_XCNT(j)]); sum += c; cnt += (c > 0u) ? 1u : 0u; mine = (j == x) ? c : mine; }
        if (sum == G) break;
        __builtin_amdgcn_s_sleep(1);
        if ((++sp & 255u) == 0u) { if (xb_ld(&bar[XB_TMO])) break; if (sp > XB_SPIN_CAP) { atomicAdd(&bar[XB_TMO], 1u); break; } }
    }
    nloc = mine > 0u ? mine : 1u; nx = cnt > 0u ? cnt : 1u;
}
__device__ __forceinline__ void xcd_barrier(const XcdBarrier& b) {
    asm volatile("s_waitcnt vmcnt(0)" ::: "memory");
    __syncthreads();
    if (threadIdx.x == 0) {
        unsigned* bar = b.bar;
        __builtin_amdgcn_s_waitcnt(0);
        unsigned nloc = b.st[0], nx = b.st[1];
        if (nloc == 0u) { xcd_barrier_complete(bar, b.x, nloc, nx); b.st[0] = nloc; b.st[1] = nx; }
        const unsigned old = xb_add(&bar[XB_XSUB(b.x)], 1u);
        const unsigned gen = old / nloc;
        if (old + 1u == (gen + 1u) * nloc) {
            __builtin_amdgcn_fence(__ATOMIC_RELEASE, "agent");
            asm volatile("s_waitcnt vmcnt(0)" ::: "memory");
            const unsigned og = xb_add(&bar[XB_TOP], 1u);
            const unsigned tg = og / nx;
            if (og + 1u == (tg + 1u) * nx) xb_add(&bar[XB_TOPGEN], 1u);
            else XB_SPIN(xb_ld(&bar[XB_TOPGEN]) == tg, bar);
            __builtin_amdgcn_fence(__ATOMIC_ACQUIRE, "agent");
            xb_add(&bar[XB_XGEN(b.x)], 1u);
            asm volatile("s_waitcnt vmcnt(0)" ::: "memory");
        } else {
            XB_SPIN(xb_ld(&bar[XB_XGEN(b.x)]) == gen, bar);
            __builtin_amdgcn_fence(__ATOMIC_ACQUIRE, "agent");
            asm volatile("s_waitcnt vmcnt(0)" ::: "memory");
        }
    }
    __syncthreads();
}

__device__ __forceinline__ void transpose_item(const float* W, int ldw, int k0, int n0, bf16_t* WT, int ldwt, int drow0, int dcol0, int dup_off, float scale, const float* kscale, LAS float* scr, int lane) {
#pragma unroll
    for (int i = 0; i < 32; ++i) { const int kk = 2 * i + (lane >> 5); float v = W[(size_t)(k0 + kk) * ldw + n0 + (lane & 31)] * scale; if (kscale) v *= kscale[k0 + kk]; scr[kk * 33 + (lane & 31)] = v; }
    asm volatile("s_waitcnt lgkmcnt(0)" ::: "memory");
    const int cc = lane & 7;
#pragma unroll
    for (int jj = 0; jj < 4; ++jj) { const int n = (lane >> 3) + 8 * jj; const LAS float* s = scr + (8 * cc) * 33 + n;
        u32x4 ov; ov.x = cvtpk(s[0 * 33], s[1 * 33]); ov.y = cvtpk(s[2 * 33], s[3 * 33]); ov.z = cvtpk(s[4 * 33], s[5 * 33]); ov.w = cvtpk(s[6 * 33], s[7 * 33]);
        bf16_t* dst = WT + (size_t)(drow0 + n) * ldwt + dcol0 + k0 + 8 * cc;
        *(u32x4*)dst = ov; if (dup_off) *(u32x4*)(dst + dup_off) = ov; }
    asm volatile("s_waitcnt lgkmcnt(0)" ::: "memory");
}

constexpr int LDS_BYTES = 147456, LDS_MISC_OFF = LDS_BYTES - 64;
__device__ __forceinline__ void tr_load(const float* W, int ldw, int k0, int n0, float scale, float (&v)[32], int lane, const float* kscale = nullptr) {
#pragma unroll
    for (int i = 0; i < 32; ++i) { const int kk = 2 * i + (lane >> 5); v[i] = W[(size_t)(k0 + kk) * ldw + n0 + (lane & 31)] * scale; }
    if (kscale) {
#pragma unroll
        for (int i = 0; i < 32; ++i) v[i] *= kscale[k0 + 2 * i + (lane >> 5)];
    }
}
__device__ __forceinline__ void tr_store(const float (&v)[32], bf16_t* WT, int ldwt, int drow0, int k0, LAS float* scr, int lane) {
#pragma unroll
    for (int i = 0; i < 32; ++i) { const int kk = 2 * i + (lane >> 5); scr[kk * 33 + (lane & 31)] = v[i]; }
    asm volatile("s_waitcnt lgkmcnt(0)" ::: "memory");
    const int cc = lane & 7;
#pragma unroll
    for (int jj = 0; jj < 4; ++jj) { const int n = (lane >> 3) + 8 * jj; const LAS float* sp = scr + (8 * cc) * 33 + n;
        u32x4 ov; ov.x = cvtpk(sp[0 * 33], sp[1 * 33]); ov.y = cvtpk(sp[2 * 33], sp[3 * 33]); ov.z = cvtpk(sp[4 * 33], sp[5 * 33]); ov.w = cvtpk(sp[6 * 33], sp[7 * 33]);
        *(u32x4*)(WT + (size_t)(drow0 + n) * ldwt + k0 + 8 * cc) = ov; }
    asm volatile("s_waitcnt lgkmcnt(0)" ::: "memory");
}
__device__ __forceinline__ void w1t_item(int it, const float* w_in, const float* w_gate, const float*& src, int& ldw, int& k0, int& n0, int& drow0, float& sc) {
    const int kb = it >> 8, nb = it & 255, blk = nb >> 5, nin = (nb & 31) * 32;
    const float cq_sb = LOG2E * 0.08838834764831845f, cq_df = LOG2E * 0.125f;
    sc = 1.f; src = w_in; ldw = 6144;
    switch (blk) {
        case 0: n0 = 0 + nin; sc = cq_sb; break;
        case 1: n0 = 1024 + nin; break;
        case 2: n0 = 3072 + nin; sc = cq_df; break;
        case 3: n0 = 4096 + nin; break;
        case 4: src = w_gate; ldw = 2048; n0 = nin; break;
        case 5: src = w_gate; ldw = 2048; n0 = 1024 + nin; break;
        case 6: n0 = 2048 + nin; break;
        default: n0 = 5120 + nin; break;
    }
    k0 = kb * 64; drow0 = nb * 32;
}

struct Args { const float* in[19]; float* out; unsigned char* ws; int ph_lo, ph_hi; };

__global__ void __launch_bounds__(NTHREADS, 2) fwd_kernel(Args args) {
    extern __shared__ __attribute__((aligned(16))) unsigned char lds_raw[];
    LAS unsigned char* lds = (LAS unsigned char*)lds_raw;
    const int tid = threadIdx.x, lane = tid & 63, wid = __builtin_amdgcn_readfirstlane(tid >> 6);
    const int G = gridDim.x, bx = blockIdx.x;
    unsigned char* ws = args.ws;
    const float* x = args.in[0];
    bf16_t* W1T = (bf16_t*)(ws + WS_W1T); bf16_t* XN = (bf16_t*)(ws + WS_XN); bf16_t* PROJ = (bf16_t*)(ws + WS_PROJ); bf16_t* GATES = (bf16_t*)(ws + WS_GATES);
    bf16_t* METAK = (bf16_t*)(ws + WS_METAK); bf16_t* METAV = (bf16_t*)(ws + WS_METAV);
    bf16_t* WBR = (bf16_t*)(ws + WS_WBR); bf16_t* WOUT2 = (bf16_t*)(ws + WS_WOUT2); bf16_t* WFFN = (bf16_t*)(ws + WS_WFFN); bf16_t* WDOWN = (bf16_t*)(ws + WS_WDOWN);
    bf16_t* H1B = (bf16_t*)(ws + WS_H1B); bf16_t* ACT = (bf16_t*)(ws + WS_ACT); float* H1 = (float*)(ws + WS_H1);
    float* SS1 = (float*)(ws + CTL_SS1); float* SS2 = (float*)(ws + CTL_SS2);
    bf16_t* VT = (bf16_t*)args.out; bf16_t* Y = (bf16_t*)args.out;
    const int gw = bx * NWAVES + wid, NGW = G * NWAVES;
    const int lo = args.ph_lo, hi = args.ph_hi;
#define IN(k) (lo <= (k) && (k) < hi)
#ifdef PROBE_A
    unsigned long long* tsw = (unsigned long long*)(ws + 2048);
#define STAMP(i) do { if (bx == 0 && tid == 0) tsw[i] = __builtin_amdgcn_s_memrealtime(); } while (0)
#else
#define STAMP(i) do {} while (0)
#endif
#if MK_N_LAUNCHES == 1
    volatile LAS unsigned* bar_st = (volatile LAS unsigned*)(lds + LDS_MISC_OFF);
    if (tid < 2) bar_st[tid] = 0u;
    __syncthreads();
    const XcdBarrier gbar = xcd_barrier_post((unsigned*)(ws + CTL_BAR), bar_st);
    if (args.ph_lo < 0) cg::this_grid().sync();
#define GRID_BAR() xcd_barrier(gbar)
#else
#define GRID_BAR() do {} while (0)
#endif

    STAMP(0);
    if (IN(0)) {
        LAS float* scr = (LAS float*)(lds + wid * 16384);
        const float* w_in = args.in[3]; const float* w_gate = args.in[4];
        {   const bool split = (G >= 256);
            const int cw = split ? (bx >= 128 ? (bx - 128) * NWAVES + wid : -1) : gw, NCW = split ? (G - 128) * NWAVES : NGW;
            if (cw >= 0) for (int it = cw; it < 16 * 256; it += 2 * NCW) {
                const bool hasB = (it + NCW < 16 * 256);
                const float* sa; const float* sb; int la, lb, ka, kb2, na, nb2, da, db; float ca, cb;
                w1t_item(it, w_in, w_gate, sa, la, ka, na, da, ca);
                w1t_item(hasB ? it + NCW : it, w_in, w_gate, sb, lb, kb2, nb2, db, cb);
                float va[32], vb[32];
                tr_load(sa, la, ka, na, ca, va, lane);
                if (hasB) tr_load(sb, lb, kb2, nb2, cb, vb, lane);
                tr_store(va, W1T, 1024, da, ka, scr, lane);
                if (hasB) tr_store(vb, W1T, 1024, db, kb2, scr, lane);
            }
        }
        {   const float* g = args.in[2];
            f32x4 gv[4];
#pragma unroll
            for (int jj = 0; jj < 4; ++jj) gv[jj] = *((const f32x4*)g + lane + 64 * jj);
            for (int m0 = gw; m0 < MROWS; m0 += 8 * NGW) {
                f32x4 v[8][4];
#pragma unroll
                for (int q = 0; q < 8; ++q) { const int m = m0 + q * NGW; if (m < MROWS) { const f32x4* xr = (const f32x4*)(x + (size_t)m * DM) + lane;
#pragma unroll
                    for (int jj = 0; jj < 4; ++jj) v[q][jj] = xr[64 * jj]; } }
#pragma unroll
                for (int q = 0; q < 8; ++q) { const int m = m0 + q * NGW; if (m < MROWS) { float s = 0.f;
#pragma unroll
                    for (int jj = 0; jj < 4; ++jj) s += (v[q][jj].x * v[q][jj].x + v[q][jj].y * v[q][jj].y) + (v[q][jj].z * v[q][jj].z + v[q][jj].w * v[q][jj].w);
                    const float rstd = __builtin_amdgcn_rsqf(wave_sum(s) * (1.0f / DM) + EPS);
                    u32x2* o8 = (u32x2*)(XN + (size_t)m * DM) + lane;
#pragma unroll
                    for (int jj = 0; jj < 4; ++jj) { u32x2 w; w.x = cvtpk(v[q][jj].x * rstd * gv[jj].x, v[q][jj].y * rstd * gv[jj].y); w.y = cvtpk(v[q][jj].z * rstd * gv[jj].z, v[q][jj].w * rstd * gv[jj].w); o8[64 * jj] = w; } } }
            }
        }
        if (bx < 128) {
            __syncthreads();
            LAS float* xm = (LAS float*)lds;
            LAS float* part = (LAS float*)(lds + 65536);
            LAS float* res = (LAS float*)(lds + 65536 + 32768);
            const float* meta = args.in[1]; const float* g = args.in[2];
            for (int rr = 0; rr < 2; ++rr) { const int row = 2 * wid + rr; const f32x4* xr = (const f32x4*)(meta + (size_t)row * DM) + lane; f32x4 v[4]; float s = 0.f;
#pragma unroll
                for (int jj = 0; jj < 4; ++jj) { v[jj] = xr[64 * jj]; s += (v[jj].x * v[jj].x + v[jj].y * v[jj].y) + (v[jj].z * v[jj].z + v[jj].w * v[jj].w); }
                const float rstd = __builtin_amdgcn_rsqf(wave_sum(s) * (1.0f / DM) + EPS);
#pragma unroll
                for (int jj = 0; jj < 4; ++jj) { const f32x4 gg = *((const f32x4*)g + lane + 64 * jj); f32x4 w = v[jj] * rstd * gg; *(LAS f32x4*)(xm + row * 1024 + 4 * (lane + 64 * jj)) = w; } }
            __syncthreads();
            const int cl = tid & 31, ksl = tid >> 5, blk = bx >> 5, col = (bx & 31) * 32 + cl;
            const int srcc = (blk == 0 ? 1024 : blk == 1 ? 2048 : blk == 2 ? 4096 : 5120) + col;
            float acc[16];
#pragma unroll
            for (int i = 0; i < 16; ++i) acc[i] = 0.f;
#pragma unroll 8
            for (int k = ksl * 64; k < ksl * 64 + 64; ++k) { const float w = w_in[(size_t)k * 6144 + srcc];
#pragma unroll
                for (int i = 0; i < 16; ++i) acc[i] = __builtin_fmaf(xm[i * 1024 + k], w, acc[i]); }
#pragma unroll
            for (int i = 0; i < 16; ++i) part[(ksl * 16 + i) * 32 + cl] = acc[i];
            __syncthreads();
            {   const int i = tid >> 5; float v = 0.f;
#pragma unroll
                for (int ks2 = 0; ks2 < 16; ++ks2) v += part[(ks2 * 16 + i) * 32 + cl];
                res[i * 32 + cl] = v;
                if (blk == 2) { float q = v * v; q += __shfl_xor(q, 1); q += __shfl_xor(q, 2); q += __shfl_xor(q, 4); q += __shfl_xor(q, 8); q += __shfl_xor(q, 16);
                    if (cl == 0) { unsigned* nk = (unsigned*)(ws + CTL_NK); const int id = bx & 31; atomicMax(nk + id, __float_as_uint(q)); atomicMax(nk + 32 + id, __float_as_uint(q)); } }
                if (blk == 0 || blk == 2) {
                    const int dcol = (blk == 2 ? PC_DFK : PC_SBK) + col;
                    METAK[(size_t)i * PROJ_LD + dcol] = (bf16_t)(cvtpk(v, 0.f) & 0xffffu);
#pragma unroll
                    for (int q3 = 1; q3 < 4; ++q3) METAK[(size_t)(16 * q3 + i) * PROJ_LD + dcol] = (bf16_t)0;
                }
            }
            __syncthreads();
            if ((blk == 1 || blk == 3) && tid < 32) {
                float v[16];
#pragma unroll
                for (int i = 0; i < 16; ++i) v[i] = res[i * 32 + cl];
                bf16_t* dst = METAV + (size_t)((blk == 3 ? 1024 : 0) + col) * 64;
                u32x4 w0, w1; const u32x4 z = {0u, 0u, 0u, 0u};
                w0.x = cvtpk(v[0], v[1]); w0.y = cvtpk(v[2], v[3]); w0.z = cvtpk(v[4], v[5]); w0.w = cvtpk(v[6], v[7]);
                w1.x = cvtpk(v[8], v[9]); w1.y = cvtpk(v[10], v[11]); w1.z = cvtpk(v[12], v[13]); w1.w = cvtpk(v[14], v[15]);
                *(u32x4*)(dst) = w0; *(u32x4*)(dst + 8) = w1;
#pragma unroll
                for (int i = 2; i < 8; ++i) *(u32x4*)(dst + 8 * i) = z;
            }
        }
        if (IN(1)) GRID_BAR();
        STAMP(1);
    }

    if (IN(1)) {
        SchedP1 S{(const char*)XN, (const char*)W1T, G, bx};
        EpiP1 E{PROJ, GATES, VT, args.in[5], (unsigned*)(ws + CTL_NK)};
        pg8::gemm_phase<EpiP1, SchedP1, true>(lds, 1024, 1024, 1024, S, E);
        if (IN(2)) GRID_BAR();
        STAMP(2);
    }

    if (IN(2)) {
        {   LAS float* scr = (LAS float*)(lds + wid * 16384);
            const float* w_br_sb = args.in[11]; const float* w_br_df = args.in[12]; const float* w_out = args.in[13]; const float* gffn = args.in[14];
            const float* w_fg = args.in[15]; const float* w_fu = args.in[16]; const float* w_fd = args.in[17];
            constexpr int I_BR = 16 * 32, I_FFN = 16 * 176, I_DN = 44 * 32, I_ALL = 3 * I_BR + I_FFN + I_DN;
#define CONV_ITEM(it_, src, dst, ksc, ldw, ldwt, k0, n0, drow0) do { const int it = (it_); ksc = nullptr; \
                if (it < 3 * I_BR) { const int w = it / I_BR, q = it % I_BR; src = (w == 0) ? w_br_sb : (w == 1) ? w_br_df : w_out; dst = (w == 2) ? WOUT2 : WBR; \
                    ldw = 1024; ldwt = 1024; k0 = (q >> 5) * 64; n0 = (q & 31) * 32; drow0 = (w == 1 ? 1024 : 0) + n0; } \
                else if (it < 3 * I_BR + I_FFN) { const int q = it - 3 * I_BR, kb = q / 176, nb = q % 176, R = nb * 32, p = R >> 8, rr = R & 255; \
                    src = (rr < 128) ? w_fg : w_fu; dst = WFFN; ksc = gffn; ldw = DFF; ldwt = 1024; k0 = kb * 64; n0 = 128 * p + (rr & 127); drow0 = R; } \
                else { const int q = it - 3 * I_BR - I_FFN; src = w_fd; dst = WDOWN; ldw = 1024; ldwt = DFF; k0 = (q >> 5) * 64; n0 = (q & 31) * 32; drow0 = n0; } } while (0)
            for (int it0 = gw; it0 < I_ALL; it0 += 2 * NGW) {
                const bool hasB = (it0 + NGW < I_ALL);
                const float *sa, *sb, *ga, *gb; bf16_t *da, *db; int la, lb, lta, ltb, ka, kb2, na, nb2, ra, rb;
                CONV_ITEM(it0, sa, da, ga, la, lta, ka, na, ra);
                CONV_ITEM(hasB ? it0 + NGW : it0, sb, db, gb, lb, ltb, kb2, nb2, rb);
                float va[32], vb[32];
                tr_load(sa, la, ka, na, 1.f, va, lane, ga);
                if (hasB) tr_load(sb, lb, kb2, nb2, 1.f, vb, lane, gb);
                tr_store(va, da, lta, ra, ka, scr, lane);
                if (hasB) tr_store(vb, db, ltb, rb, kb2, scr, lane);
            }
#undef CONV_ITEM
        }
        __syncthreads();
        att::Ctx c; c.PROJ = PROJ; c.PROJW = PROJ; c.VT = VT; c.METAK = METAK; c.METAV = METAV; c.subln = args.in[10]; c.nk = (const float*)(ws + CTL_NK); c.queue = (unsigned*)(ws + CTL_QUEUE); c.lds = lds; c.tid = tid; c.lane = lane; c.wid = wid; c.r = lane & 31; c.h = lane >> 5;
        {   const float a1 = args.in[6][lane] * args.in[7][lane], a2 = args.in[8][lane] * args.in[9][lane];
            const float lamv = __expf(wave_sum(a1)) - __expf(wave_sum(a2)) + 0.2f; c.lam = __uint_as_float(__builtin_amdgcn_readfirstlane(__float_as_uint(lamv))); }
        LAS unsigned* flags = (LAS unsigned*)(lds + att::FLAG_OFF);
        if (tid < 8) flags[tid] = 0u;
        __syncthreads();
        unsigned* queue = (unsigned*)(ws + CTL_QUEUE);
        if (tid == 0) flags[4] = atomicAdd(queue, 1u);
        __syncthreads();
        for (;;) {
            const unsigned u = flags[4];
            __syncthreads();
            if (u >= 1536u) break;
            if (u < 1024u) {
#ifndef NO_DF
                const int qb = 63 - (int)(u >> 4), hb = (int)(u & 15), hd = 7 - (hb >> 1), b = hb & 1; att::df_unit(c, b, hd, qb);
#endif
            }
            else {
#ifndef NO_SB
                const unsigned v = u - 1024u; const int qb = 31 - (int)(v >> 4), hb = (int)(v & 15), hd = hb >> 1, b = hb & 1; att::sb_unit(c, b, hd, qb);
#endif
            }
        }
        if (IN(3)) GRID_BAR();
        STAMP(3);
    }

    if (IN(3)) {
        SchedP3 S{(const char*)PROJ, (const char*)WBR, G, bx};
        EpiP3 E{GATES, Y};
        pg8::gemm_phase<EpiP3, SchedP3, true>(lds, 1024, PROJ_LD, 1024, S, E);
        if (IN(4)) GRID_BAR();
        STAMP(4);
    }

    if (IN(4)) {
        SchedN1024 S{(const char*)Y, (const char*)WOUT2, (size_t)1024 * 2, (size_t)1024 * 2, G, bx};
        EpiRes E{x, nullptr, H1B, SS1};
        pg8::gemm_phase<EpiRes, SchedN1024, true>(lds, 1024, 1024, 1024, S, E);
        if (IN(5)) GRID_BAR();
        STAMP(5);
    }

    if (IN(5)) {
        SchedP5 S{(const char*)H1B, (const char*)WFFN, G, bx};
        EpiP5 E{SS1, ACT};
        pg8::gemm_phase<EpiP5, SchedP5, true>(lds, 1024, 1024, 1024, S, E);
        if (IN(6)) GRID_BAR();
        STAMP(6);
    }

    if (IN(6)) {
        SchedN1024 S{(const char*)ACT, (const char*)WDOWN, (size_t)DFF * 2, (size_t)DFF * 2, G, bx};
        EpiFinal E{H1B, args.out, SS2, (unsigned*)(ws + CTL_PCNT), args.in[18]};
        pg8::gemm_phase<EpiFinal, SchedN1024, true>(lds, DFF, DFF, DFF, S, E);
        STAMP(7);
#ifdef PROBE_A
        GRID_BAR();
        if (bx == 0) { const unsigned long long d = tsw[PROBE_B] - tsw[PROBE_A]; const int K = (int)(d / 4); for (int i = tid; i < K && i < MROWS * DM; i += NTHREADS) args.out[i] += 0.1f; }
#endif
    }

#undef IN
}

extern "C" void kernel_launch(void* const* d_in, const int* in_sizes, int n_in, void* d_out, int out_size, void* d_ws, size_t ws_size, hipStream_t stream) {
    static int grid = 0;
    if (grid == 0) {
        if (n_in != 19 || out_size != MROWS * DM || ws_size < WS_END) { fprintf(stderr, "kernel_launch: unexpected shapes (n_in %d out %d ws %zu)\n", n_in, out_size, ws_size); grid = -1; return; }
        int dev = 0, cus = 0, per_cu = 0;
        hipGetDevice(&dev); hipDeviceGetAttribute(&cus, hipDeviceAttributeMultiprocessorCount, dev);
        if (hipFuncSetAttribute((const void*)fwd_kernel, hipFuncAttributeMaxDynamicSharedMemorySize, LDS_BYTES) != hipSuccess) { fprintf(stderr, "kernel_launch: hipFuncSetAttribute failed\n"); grid = -1; return; }
        if (hipOccupancyMaxActiveBlocksPerMultiprocessor(&per_cu, (const void*)fwd_kernel, NTHREADS, LDS_BYTES) != hipSuccess || per_cu < 1) { fprintf(stderr, "kernel_launch: occupancy query says %d\n", per_cu); per_cu = 1; }
        (void)hipGetLastError();
        grid = cus * 1;
    }
    if (grid < 0) return;
    (void)hipMemsetAsync((char*)d_ws + WS_CTL, 0, CTL_BYTES, stream);
    Args a{};
    for (int i = 0; i < 19; ++i) a.in[i] = (const float*)d_in[i];
    a.out = (float*)d_out; a.ws = (unsigned char*)d_ws;
#if MK_N_LAUNCHES == 1
    a.ph_lo = 0; a.ph_hi = 7;
    void* kargs[] = {&a};
    hipError_t e = hipLaunchCooperativeKernel((const void*)fwd_kernel, dim3(grid), dim3(NTHREADS), kargs, LDS_BYTES, stream);
    if (e != hipSuccess) fprintf(stderr, "kernel_launch: cooperative launch failed: %s (grid %d)\n", hipGetErrorString(e), grid);
#else
    for (int p = 0; p < 7; ++p) { a.ph_lo = p; a.ph_hi = p + 1; hipLaunchKernelGGL(fwd_kernel, dim3(grid), dim3(NTHREADS), LDS_BYTES, stream, a); }
#endif
}
```
